# Optimizing an MI355X kernel written in HIP

```python
import functools
import jax
import jax.numpy as jnp
from jax import lax
import numpy as np

D_MODEL = 2048
BATCH = 4
SEQ = 8192
DEPTH = 1

CTX_LEN = 256
GRID_W = 64
CHUNK = 128
EPS = 1e-6
ADA_CHUNKS = 6

R_HEADS = 8
R_DK = 64
R_DV = 128
R_QK = R_HEADS * R_DK
R_WIDTH = R_HEADS * R_DV
ROPE_BASE = 10000.0

M_HEADS = 4
M_DK = 128
M_DV = 256
M_QK = M_HEADS * M_DK
M_WIDTH = M_HEADS * M_DV
M_CONV = 3
M_N_GATES = 2 * 2 * M_HEADS

P_HEADS = 8
P_NKEYS = 128
P_EXPERTS = P_NKEYS * P_NKEYS
P_DQ = 256
P_TOPK = 16
P_BLOCK = 128

IN_SPLITS = (R_QK, R_QK, R_WIDTH, R_WIDTH, M_QK, M_QK, M_WIDTH, M_WIDTH, M_N_GATES, D_MODEL, D_MODEL)
IN_COLS = 2 * R_QK + 2 * R_WIDTH + 2 * M_QK + 2 * M_WIDTH + M_N_GATES + 2 * D_MODEL

kernel_name = 'hybrid_retention_mlstm_peer_dit'


def _split_in(p):
    out, off = [], 0
    for size in IN_SPLITS:
        out.append(p[..., off:off + size])
        off += size
    return out


def _rmsnorm(x, g):
    xf = x.astype(jnp.float32)
    y = xf * lax.rsqrt(jnp.mean(xf * xf, axis=-1, keepdims=True) + EPS)
    return (y * g.astype(jnp.float32)).astype(x.dtype)


def _modulate(x, g, shift, scale):
    return _rmsnorm(x, g) * (1.0 + scale) + shift


def _head_norm(y):
    yc = y - jnp.mean(y, axis=-1, keepdims=True)
    return yc * lax.rsqrt(jnp.mean(yc * yc, axis=-1, keepdims=True) + EPS)


def _rotary_2d(t, row, col):
    half = t.shape[-1] // 2
    n_ax = half // 2
    freq = ROPE_BASE ** (-jnp.arange(n_ax, dtype=jnp.float32) / n_ax)
    ang = jnp.concatenate([row[:, None] * freq, col[:, None] * freq], axis=-1)
    cos = jnp.cos(ang)[None, :, None, :]
    sin = jnp.sin(ang)[None, :, None, :]
    t1, t2 = t[..., :half], t[..., half:]
    return jnp.concatenate([t1 * cos - t2 * sin, t2 * cos + t1 * sin], axis=-1)


def _to_chunks(t):
    bsz, length = t.shape[:2]
    t = t.reshape((bsz, length // CHUNK, CHUNK) + t.shape[2:])
    return jnp.swapaxes(jnp.moveaxis(t, 1, 0), 2, 3)


def _from_chunks(t):
    t = jnp.moveaxis(jnp.swapaxes(t, 2, 3), 0, 1)
    return t.reshape((t.shape[0], t.shape[1] * t.shape[2]) + t.shape[3:])


def _flip(ts):
    return tuple(jnp.flip(t, axis=1) for t in ts)


def _bidirectional(scan_f, scan_b, lat_f, lat_b, ctx_f, ctx_b, init, need_ctx):
    st_f, yc_f = scan_f(ctx_f, init, need_ctx)
    st_b, yc_b = scan_b(_flip(ctx_b), init, need_ctx)
    _, yl_f = scan_f(lat_f, st_f, True)
    _, yl_b = scan_b(_flip(lat_b), st_b, True)
    y_lat = yl_f + jnp.flip(yl_b, axis=1)
    y_ctx = yc_f + jnp.flip(yc_b, axis=1) if need_ctx else None
    return y_lat, y_ctx


def _retention_scan(seqs, s0, with_out, log_gamma):
    q, k, v = (_to_chunks(t) for t in seqs)
    pos = jnp.arange(CHUNK, dtype=jnp.float32)
    lg = log_gamma[:, None]
    rel = pos[:, None] - pos[None, :]
    intra = jnp.where(rel >= 0, jnp.exp(lg[:, :, None] * jnp.maximum(rel, 0.0)), 0.0)
    q_dec = jnp.exp(lg * (pos + 1.0))[None, :, :, None]
    k_dec = jnp.exp(lg * (CHUNK - 1.0 - pos))[None, :, :, None]
    c_dec = jnp.exp(lg * CHUNK)[None, :, :, None]

    def step(s, inp):
        qc, kc, vc = inp
        s_new = c_dec * s + jnp.einsum('bhcd,bhce->bhde', kc * k_dec, vc)
        if not with_out:
            return s_new, None
        att = jnp.einsum('bhcd,bhsd->bhcs', qc, kc) * intra
        y = jnp.einsum('bhcs,bhse->bhce', att, vc) + jnp.einsum('bhcd,bhde->bhce', qc * q_dec, s)
        return s_new, y

    s_fin, ys = lax.scan(step, s0, (q, k, v))
    return s_fin, (_from_chunks(ys) if with_out else None)


def _mlstm_scan(seqs, state0, with_out):
    q, k, v, ig, lf = (_to_chunks(t) for t in seqs)
    tri = jnp.tril(jnp.ones((CHUNK, CHUNK), dtype=bool))

    def step(carry, inp):
        c_prev, n_prev, m_prev = carry
        qc, kc, vc, ic, fc = inp
        b = jnp.cumsum(fc, axis=-1)
        b_end = b[..., -1]
        w_log = b_end[..., None] - b + ic
        a_end = b_end + m_prev
        m_new = jnp.maximum(a_end, jnp.max(w_log, axis=-1))
        p = jnp.exp(a_end - m_new)
        kw = kc * jnp.exp(w_log - m_new[..., None])[..., None]
        c_new = p[..., None, None] * c_prev + jnp.einsum('bhcd,bhce->bhde', kw, vc)
        n_new = p[..., None] * n_prev + jnp.sum(kw, axis=2)
        new = (c_new, n_new, m_new)
        if not with_out:
            return new, None
        a = b + m_prev[..., None]
        d_log = jnp.where(tri, b[..., :, None] - b[..., None, :] + ic[..., None, :], -jnp.inf)
        m_t = jnp.maximum(a, jnp.max(d_log, axis=-1))
        att = jnp.einsum('bhcd,bhsd->bhcs', qc, kc) * jnp.exp(d_log - m_t[..., None])
        inter = jnp.exp(a - m_t)[..., None]
        num = jnp.einsum('bhcs,bhse->bhce', att, vc) + inter * jnp.einsum('bhcd,bhde->bhce', qc, c_prev)
        den = jnp.sum(att, axis=-1, keepdims=True) + inter * jnp.einsum('bhcd,bhd->bhc', qc, n_prev)[..., None]
        h = num / jnp.maximum(jnp.abs(den), jnp.exp(-m_t)[..., None])
        return new, h

    st, hs = lax.scan(step, state0, (q, k, v, ig, lf))
    return st, (_from_chunks(hs) if with_out else None)


def _retention_inputs(q, k, v, row, col):
    bsz, length = q.shape[:2]
    qh = q.reshape(bsz, length, R_HEADS, R_DK).astype(jnp.float32)
    kh = k.reshape(bsz, length, R_HEADS, R_DK).astype(jnp.float32)
    if row is not None:
        qh = _rotary_2d(qh, row, col)
        kh = _rotary_2d(kh, row, col)
    vh = v.reshape(bsz, length, R_HEADS, R_DV).astype(jnp.float32)
    return (qh, kh * (R_DK ** -0.5), vh)


def _dwconv_centred(x, w):
    ksz, ch = w.shape
    return lax.conv_general_dilated(x, w[:, None, :].astype(x.dtype), window_strides=(1,),
                                    padding=[(ksz // 2, ksz - 1 - ksz // 2)],
                                    dimension_numbers=('NWC', 'WIO', 'NWC'), feature_group_count=ch)


def _mlstm_inputs(q, k, v, gates, conv_w, gate_bias):
    bsz, length = q.shape[:2]
    qk = jax.nn.silu(_dwconv_centred(jnp.concatenate([q, k], axis=-1), conv_w))
    qh = qk[..., :M_QK].reshape(bsz, length, M_HEADS, M_DK).astype(jnp.float32)
    kh = qk[..., M_QK:].reshape(bsz, length, M_HEADS, M_DK).astype(jnp.float32) * (M_DK ** -0.5)
    vh = v.reshape(bsz, length, M_HEADS, M_DV).astype(jnp.float32)
    g = gates.astype(jnp.float32).reshape(bsz, length, 2, 2, M_HEADS) + gate_bias.astype(jnp.float32)
    fwd = (qh, kh, vh, g[:, :, 0, 0], jax.nn.log_sigmoid(g[:, :, 0, 1]))
    bwd = (qh, kh, vh, g[:, :, 1, 0], jax.nn.log_sigmoid(g[:, :, 1, 1]))
    return fwd, bwd


def _retention_out(y, gate):
    bsz, length = y.shape[:2]
    return _head_norm(y).reshape(bsz, length, R_WIDTH).astype(gate.dtype) * jax.nn.silu(gate)


def _mlstm_out(h, o):
    bsz, length = h.shape[:2]
    return _head_norm(h).reshape(bsz, length, M_WIDTH).astype(o.dtype) * jax.nn.sigmoid(o)


def _merge(yr, ym, g_r, g_m, w_ret_out, w_mlstm_out, w_out):
    merged = jax.nn.sigmoid(g_r) * (yr @ w_ret_out) + jax.nn.sigmoid(g_m) * (ym @ w_mlstm_out)
    return merged @ w_out


def _peer(h, w_query, sub_keys, expert_down, expert_up):
    bsz, length, dm = h.shape
    tokens = h.reshape(-1, P_BLOCK, dm)

    def block(tb):
        qh = (tb @ w_query).reshape(P_BLOCK, P_HEADS, 2, P_DQ // 2)
        s = jnp.einsum('thpd,hpkd->thpk', qh, sub_keys).astype(jnp.float32)
        sv, si = lax.top_k(s, P_TOPK)
        cand_s = (sv[:, :, 0, :, None] + sv[:, :, 1, None, :]).reshape(P_BLOCK, P_HEADS, P_TOPK * P_TOPK)
        cand_i = (si[:, :, 0, :, None] * P_NKEYS + si[:, :, 1, None, :]).reshape(P_BLOCK, P_HEADS, P_TOPK * P_TOPK)
        best_s, best_j = lax.top_k(cand_s, P_TOPK)
        eid = jnp.take_along_axis(cand_i, best_j, axis=-1)
        g = jax.nn.softmax(best_s, axis=-1)
        act = jax.nn.gelu(jnp.einsum('thkd,td->thk', expert_down[eid], tb).astype(jnp.float32), approximate=False)
        return jnp.einsum('thk,thkd->td', (g * act).astype(tb.dtype), expert_up[eid])

    return lax.map(block, tokens).reshape(bsz, length, dm)


def _layer(x, ctx, c, c_ctx, row, col, w_ada, b_ada, norm1_g, w_in, ret_decay, m_conv, m_gate_bias,
           w_ret_out, w_mlstm_out, w_out, norm2_g, peer_query, peer_keys, peer_down, peer_up, update_ctx):
    f32 = jnp.float32
    bsz = x.shape[0]
    sh1, sc1, gt1, sh2, sc2, gt2 = jnp.split((jax.nn.silu(c) @ w_ada + b_ada)[:, None, :], ADA_CHUNKS, axis=-1)
    csh1, csc1, cgt1, csh2, csc2, cgt2 = jnp.split(jax.nn.silu(c_ctx) @ w_ada + b_ada, ADA_CHUNKS, axis=-1)
    rq, rk, rv, rg, mq, mk, mv, mo, mg, gr, gm = _split_in(_modulate(x, norm1_g, sh1, sc1) @ w_in)
    crq, crk, crv, crg, cmq, cmk, cmv, cmo, cmg, cgr, cgm = _split_in(_modulate(ctx, norm1_g, csh1, csc1) @ w_in)

    log_gamma = jax.nn.log_sigmoid(ret_decay.astype(f32))
    r_lat = _retention_inputs(rq, rk, rv, row, col)
    r_ctx = _retention_inputs(crq, crk, crv, None, None)
    s0 = jnp.zeros((bsz, R_HEADS, R_DK, R_DV), f32)
    yr, yr_c = _bidirectional(functools.partial(_retention_scan, log_gamma=log_gamma[0]),
                              functools.partial(_retention_scan, log_gamma=log_gamma[1]),
                              r_lat, r_lat, r_ctx, r_ctx, s0, update_ctx)

    m_lat_f, m_lat_b = _mlstm_inputs(mq, mk, mv, mg, m_conv, m_gate_bias)
    m_ctx_f, m_ctx_b = _mlstm_inputs(cmq, cmk, cmv, cmg, m_conv, m_gate_bias)
    m0 = (jnp.zeros((bsz, M_HEADS, M_DK, M_DV), f32), jnp.zeros((bsz, M_HEADS, M_DK), f32),
          jnp.zeros((bsz, M_HEADS), f32))
    ym, ym_c = _bidirectional(_mlstm_scan, _mlstm_scan, m_lat_f, m_lat_b, m_ctx_f, m_ctx_b, m0, update_ctx)

    x = x + gt1 * _merge(_retention_out(yr, rg), _mlstm_out(ym, mo), gr, gm, w_ret_out, w_mlstm_out, w_out)
    x = x + gt2 * _peer(_modulate(x, norm2_g, sh2, sc2), peer_query, peer_keys, peer_down, peer_up)
    if update_ctx:
        ctx = ctx + cgt1 * _merge(_retention_out(yr_c, crg), _mlstm_out(ym_c, cmo), cgr, cgm,
                                  w_ret_out, w_mlstm_out, w_out)
        ctx = ctx + cgt2 * _peer(_modulate(ctx, norm2_g, csh2, csc2), peer_query, peer_keys, peer_down, peer_up)
    return x, ctx


def setup_inputs(seed: int = 0) -> dict:
    key = jax.random.key(seed)
    ks = jax.random.split(key, 24)
    f32 = jnp.float32

    def nrm(k, shape, scale):
        return jax.random.normal(k, shape, f32) * scale

    x = nrm(ks[0], (BATCH, SEQ, D_MODEL), 1.0)
    c = nrm(ks[1], (BATCH, D_MODEL), 1.0)
    ctx = nrm(ks[2], (BATCH, CTX_LEN, D_MODEL), 1.0)
    c_ctx = nrm(ks[3], (D_MODEL,), 1.0)
    w_ada = nrm(ks[4], (DEPTH, D_MODEL, ADA_CHUNKS * D_MODEL), D_MODEL ** -0.5)
    b_ada = nrm(ks[5], (DEPTH, ADA_CHUNKS * D_MODEL), 0.02)
    norm1_g = 1.0 + nrm(ks[6], (DEPTH, D_MODEL), 0.02)
    w_in = nrm(ks[7], (DEPTH, D_MODEL, IN_COLS), D_MODEL ** -0.5)
    decay_logit = jnp.log(2.0 ** (5.0 + jnp.arange(R_HEADS, dtype=f32)) - 1.0)
    ret_decay = decay_logit[None, None, :] + nrm(ks[8], (DEPTH, 2, R_HEADS), 0.05)
    m_conv = nrm(ks[9], (DEPTH, M_CONV, 2 * M_QK), M_CONV ** -0.5)
    gate_base = jnp.stack([jnp.zeros((M_HEADS,), f32), jnp.linspace(3.0, 6.0, M_HEADS, dtype=f32)])
    m_gate_bias = gate_base[None, None] + nrm(ks[10], (DEPTH, 2, 2, M_HEADS), 0.1)
    w_ret_out = nrm(ks[11], (DEPTH, R_WIDTH, D_MODEL), R_WIDTH ** -0.5)
    w_mlstm_out = nrm(ks[12], (DEPTH, M_WIDTH, D_MODEL), M_WIDTH ** -0.5)
    w_out = nrm(ks[13], (DEPTH, D_MODEL, D_MODEL), D_MODEL ** -0.5)
    norm2_g = 1.0 + nrm(ks[14], (DEPTH, D_MODEL), 0.02)
    peer_query = nrm(ks[15], (DEPTH, D_MODEL, P_HEADS * P_DQ), D_MODEL ** -0.5)
    peer_keys = nrm(ks[16], (DEPTH, P_HEADS, 2, P_NKEYS, P_DQ // 2), (P_DQ // 2) ** -0.5)
    peer_down = nrm(ks[17], (DEPTH, P_EXPERTS, D_MODEL), D_MODEL ** -0.5)
    peer_up = nrm(ks[18], (DEPTH, P_EXPERTS, D_MODEL), P_HEADS ** -0.5)
    final_g = 1.0 + nrm(ks[19], (D_MODEL,), 0.02)
    return {'x': x, 'c': c, 'ctx': ctx, 'c_ctx': c_ctx, 'w_ada': w_ada, 'b_ada': b_ada,
            'norm1_g': norm1_g, 'w_in': w_in, 'ret_decay': ret_decay, 'm_conv': m_conv,
            'm_gate_bias': m_gate_bias, 'w_ret_out': w_ret_out, 'w_mlstm_out': w_mlstm_out,
            'w_out': w_out, 'norm2_g': norm2_g, 'peer_query': peer_query, 'peer_keys': peer_keys,
            'peer_down': peer_down, 'peer_up': peer_up, 'final_g': final_g}


def reference(x, c, ctx, c_ctx, w_ada, b_ada, norm1_g, w_in, ret_decay, m_conv, m_gate_bias,
              w_ret_out, w_mlstm_out, w_out, norm2_g, peer_query, peer_keys, peer_down, peer_up, final_g):
    length = x.shape[1]
    ROWS = length // GRID_W
    row = jnp.repeat(jnp.arange(ROWS, dtype=jnp.float32), GRID_W)
    col = jnp.tile(jnp.arange(GRID_W, dtype=jnp.float32), ROWS)
    for layer in range(DEPTH):
        x, ctx = _layer(x, ctx, c, c_ctx, row, col, w_ada[layer], b_ada[layer], norm1_g[layer], w_in[layer],
                        ret_decay[layer], m_conv[layer], m_gate_bias[layer], w_ret_out[layer],
                        w_mlstm_out[layer], w_out[layer], norm2_g[layer], peer_query[layer],
                        peer_keys[layer], peer_down[layer], peer_up[layer], update_ctx=layer < DEPTH - 1)
    return _rmsnorm(x, final_g)
```

```cpp
#include <hip/hip_runtime.h>
#include <hip/hip_cooperative_groups.h>
#include <cstdio>
#include <cstdint>
namespace cg = cooperative_groups;

#ifndef MK_N_LAUNCHES
#define MK_N_LAUNCHES 1
#endif
#define NPHASES 15

#define LAS __attribute__((address_space(3)))
typedef unsigned short bf16_t;
typedef short bf16x8 __attribute__((ext_vector_type(8)));
typedef float f32x4 __attribute__((ext_vector_type(4)));
typedef unsigned u32x4 __attribute__((ext_vector_type(4)));
typedef unsigned u32x2 __attribute__((ext_vector_type(2)));
typedef __bf16 bf16x2_t __attribute__((ext_vector_type(2)));
typedef _Float16 half8_t __attribute__((ext_vector_type(8)));
typedef _Float16 h2v_t __attribute__((ext_vector_type(2)));

constexpr int DM = 2048, NBATCH = 4, SEQ = 8192, CTXL = 256;
constexpr int NTOK = NBATCH * SEQ;
constexpr int NCTXT = NBATCH * CTXL;
constexpr int MROWS = NTOK + NCTXT;
constexpr int LDP = 10256, NPADW = 10496;
constexpr int C_RQ = 0, C_RK = 512, C_RV = 1024, C_RG = 2048, C_MQ = 3072, C_MK = 3584, C_MV = 4096, C_MO = 5120, C_GR = 6144, C_GM = 8192, C_MG = 10240;
constexpr int NWAVES = 8, NTHR = 512;
constexpr int LDS_BYTES = 160 * 1024;
constexpr int LDS_MISC = 160 * 1024 - 64;
constexpr int LCAP = 12;

constexpr size_t KiB = 1024, MiB = 1024 * 1024;
constexpr size_t WS_CTL = 0;
constexpr size_t WS_MOD = 64 * KiB;
constexpr size_t WS_ROTC = 512 * KiB;
constexpr size_t WS_ROTS = 512 * KiB + 1 * MiB;
constexpr size_t WS_ROWSQ = 2 * MiB + 512 * KiB;
constexpr size_t WS_MSCAL = 6 * MiB + 512 * KiB;
constexpr size_t WS_MPREV = WS_MSCAL + 64 * KiB;
constexpr size_t WS_NLOC = 7 * MiB;
constexpr size_t WS_NPREV = 8 * MiB + 256 * KiB;
constexpr size_t WS_WRO = 10 * MiB;
constexpr size_t WS_WMO = 14 * MiB;
constexpr size_t WS_WO = 18 * MiB;
constexpr size_t WS_WQ = 26 * MiB;
constexpr size_t WS_KEYS = 34 * MiB;
constexpr size_t Z2 = 35 * MiB;
constexpr size_t WS_P = Z2;
constexpr size_t Z3 = 676 * MiB;
constexpr size_t WS_H1 = Z3;
constexpr size_t WS_WINT = Z3 + 132 * MiB;
constexpr size_t WS_PCTX = Z3 + 326 * MiB;
constexpr size_t WS_RST = Z3;
constexpr size_t WS_MST = Z3 + 66 * MiB;
constexpr size_t WS_YRG = Z3 + 198 * MiB;
constexpr size_t WS_YMG = Z3 + 262 * MiB;
constexpr size_t WS_U = Z3;
constexpr size_t WS_H2 = Z2;
constexpr size_t WS_DN16 = Z2 + 128 * MiB;
constexpr size_t WS_UP16 = Z2 + 192 * MiB;
constexpr size_t WS_Q = Z2 + 256 * MiB;
constexpr size_t WS_EID = Z2 + 384 * MiB;
constexpr size_t WS_GW = Z2 + 400 * MiB;
constexpr size_t WS_IDX = Z2 + 416 * MiB;
constexpr size_t WS_GJ = Z2 + 432 * MiB;
constexpr size_t WS_EW = Z2 + 464 * MiB;
constexpr size_t WS_NMAXG = Z2 + 496 * MiB;
constexpr size_t WS_OVC = Z2 + 497 * MiB;
constexpr size_t WS_OVE = Z2 + 498 * MiB;
constexpr size_t WS_END = 1024 * MiB;

__device__ __forceinline__ float bf2f(unsigned short h) { return __uint_as_float(((unsigned)h) << 16); }
__device__ __forceinline__ unsigned pk2(float lo, float hi) { unsigned r; asm("v_cvt_pk_bf16_f32 %0, %1, %2" : "=v"(r) : "v"(lo), "v"(hi)); return r; }
__device__ __forceinline__ unsigned short f2bf(float f) { return (unsigned short)(pk2(f, 0.f) & 0xffffu); }
__device__ __forceinline__ void unpack8(const u32x4 v, float* f) {
#pragma unroll
    for (int i = 0; i < 4; ++i) { f[2 * i] = __uint_as_float(v[i] << 16); f[2 * i + 1] = __uint_as_float(v[i] & 0xffff0000u); }
}
__device__ __forceinline__ u32x4 pack8(const float* f) { u32x4 o; o.x = pk2(f[0], f[1]); o.y = pk2(f[2], f[3]); o.z = pk2(f[4], f[5]); o.w = pk2(f[6], f[7]); return o; }
__device__ __forceinline__ float sigmoidf_(float x) { return 1.f / (1.f + __expf(-x)); }
__device__ __forceinline__ float logsigf_(float x) { return fminf(x, 0.f) - log1pf(expf(-fabsf(x))); }
__device__ __forceinline__ float wave_sum(float v) {
#pragma unroll
    for (int o = 1; o < 64; o <<= 1) v += __shfl_xor(v, o);
    return v;
}
__device__ __forceinline__ float wave_max(float v) {
#pragma unroll
    for (int o = 1; o < 64; o <<= 1) v = fmaxf(v, __shfl_xor(v, o));
    return v;
}
__device__ __forceinline__ float row16_sum(float v) {
    v += __shfl_xor(v, 1); v += __shfl_xor(v, 2); v += __shfl_xor(v, 4); v += __shfl_xor(v, 8); return v;
}
#define LDS_WAIT() asm volatile("s_waitcnt lgkmcnt(0)" ::: "memory")

namespace pg8 {
constexpr int BM = 256, BK = 64, HALF = 128, HTB = HALF * BK * 2, STAGE_BYTES = 8 * HTB, NXCD = 8, WGM = 8;
__host__ __device__ __forceinline__ int lds_byte(int r, int c) { const int st = (r >> 4) * 2 + (c >> 5), rr = r & 15, cc = c & 31, ob = rr * 64 + cc * 2; return st * 1024 + (ob ^ (((ob >> 9) & 1) << 5)); }
__host__ __device__ __forceinline__ void stage_rc(int b, int& R, int& C) { const int st = b / 1024, sb = b % 1024, swz = sb ^ (((sb >> 9) & 1) << 5); R = (st >> 1) * 16 + swz / 64; C = (st & 1) * 32 + (swz % 64) / 2; }
__host__ __device__ __forceinline__ int perm32(int rho) { const int n = rho >> 4, i = rho & 15; return 8 * (i >> 2) + 4 * n + (i & 3); }
struct Unit { int pm, pn; };
struct Gemm { const bf16_t* A; const bf16_t* Bt; int lda; int K; };

__device__ __forceinline__ void static_map(int L, int nM, int nN, Unit& u) {
    const int nwg = nM * nN; int wgid = L;
    { const int q = nwg / NXCD, r = nwg % NXCD, xcd = wgid % NXCD, off = wgid / NXCD; wgid = (xcd < r ? xcd * (q + 1) : r * (q + 1) + (xcd - r) * q) + off; }
    const int nig = WGM * nN, gid = wgid / nig, fm = gid * WGM, gsz = (nM - fm) < WGM ? (nM - fm) : WGM;
    u.pm = fm + ((wgid % nig) % gsz); u.pn = (wgid % nig) / gsz;
}
struct StaticOrder {
    int nM, nN, nwg, G, c;
    __device__ __forceinline__ void init(int M, int N, int G_, int c_) { nM = M / BM; nN = N / BM; nwg = nM * nN; G = G_; c = c_; }
    __device__ __forceinline__ bool next(int i, Unit& u) const { const long L = (long)i * G + c; if (L >= nwg) return false; static_map((int)L, nM, nN, u); return true; }
};
struct OrderG1 {
    int G, c;
    __device__ __forceinline__ bool next(int i, Unit& u) const {
        const long L = (long)i * G + c;
        if (L < 128 * 41) { static_map((int)L, 128, 41, u); return true; }
        const int j = (int)(L - 128 * 41); if (j >= 52) return false;
        const int t = j >> 2; u.pm = 128 + (j & 3); u.pn = (t < 6) ? (2 + t) : (t < 12 ? 14 + (t - 6) : 40); return true;
    }
};

template <class Epi, class Sched, bool ALIGN_EPI = true, bool SP2 = true>
__device__ __forceinline__ void gemm_phase(LAS unsigned char* lds, const Gemm g, const Sched& S, const Epi& E) {
    const int tid = threadIdx.x, wid = __builtin_amdgcn_readfirstlane(tid >> 6), lane = tid & 63, wr = wid >> 2, wc = wid & 3, fr = lane & 15, fq = lane >> 4;
    const int K = g.K, nt = K / BK, lda = g.lda;
    unsigned voffA[2], voffB[2];
#pragma unroll
    for (int i = 0; i < 2; ++i) { int R, C; stage_rc(tid * 16 + i * 8192, R, C); const int Rb = Epi::PERM ? ((R & ~31) + perm32(R & 31)) : R;
        voffA[i] = (unsigned)(R * lda + C) * 2u; voffB[i] = (unsigned)(Rb * K + C) * 2u; }
    const size_t kstep = (size_t)(BK * 2);
    const size_t hstepA = (size_t)HALF * lda * 2, hstepB = (size_t)HALF * K * 2;
    const size_t tstepA = 2 * hstepA, tstepB = 2 * hstepB;
    const unsigned ldsw = (unsigned)wid * 1024u;
    const int aoff = lds_byte(wr * 64 + fr, fq * 8), boff = lds_byte(wc * 32 + fr, fq * 8);
#define PG8_SA(b, h) (((b) * 2 + (h)) * HTB)
#define PG8_SB(b, h) ((4 + (b) * 2 + (h)) * HTB)
#define PG8_STAGE(bufoff, gbase, voff) do { _Pragma("unroll") for (int _i = 0; _i < 2; ++_i) \
        __builtin_amdgcn_global_load_lds((const unsigned*)((const char*)(gbase) + (voff)[_i]), (LAS unsigned*)(lds + (bufoff) + ldsw + _i * 8192), 16, 0, 0); } while (0)
#define PG8_LDA(dst, b, h) do { _Pragma("unroll") for (int m = 0; m < 4; ++m) _Pragma("unroll") for (int k = 0; k < 2; ++k) dst[m][k] = *(const LAS bf16x8*)(lds + PG8_SA(b, h) + aoff + m * 2048 + k * 1024); } while (0)
#define PG8_LDB(dst, b, h) do { _Pragma("unroll") for (int n = 0; n < 2; ++n) _Pragma("unroll") for (int k = 0; k < 2; ++k) dst[n][k] = *(const LAS bf16x8*)(lds + PG8_SB(b, h) + boff + n * 2048 + k * 1024); } while (0)
#define PG8_MMA(ai, bj, At, Bt) do { __builtin_amdgcn_s_setprio(1); _Pragma("unroll") for (int m = 0; m < 4; ++m) _Pragma("unroll") for (int n = 0; n < 2; ++n) _Pragma("unroll") for (int k = 0; k < 2; ++k) \
        acc[ai][bj][m][n] = __builtin_amdgcn_mfma_f32_16x16x32_bf16(Bt[n][k], At[m][k], acc[ai][bj][m][n], 0, 0, 0); __builtin_amdgcn_s_setprio(0); } while (0)
#define PG8_WAIT_V(n) asm volatile("s_waitcnt vmcnt(" #n ")" ::: "memory")
#define PG8_WAIT_L(n) asm volatile("s_waitcnt lgkmcnt(" #n ")" ::: "memory")
#define PG8_BAR __builtin_amdgcn_s_barrier()
#define PG8_SCHED __builtin_amdgcn_sched_barrier(0)
    Unit cur, nxt; int ui = 0;
    if (!S.next(0, cur)) return;
    f32x4 acc[2][2][4][2];
#pragma unroll
    for (int a = 0; a < 2; ++a)
#pragma unroll
        for (int b = 0; b < 2; ++b)
#pragma unroll
            for (int m = 0; m < 4; ++m)
#pragma unroll
                for (int n = 0; n < 2; ++n) acc[a][b][m][n] = (f32x4){0.f, 0.f, 0.f, 0.f};
    bf16x8 At[4][2], B0[2][2], B1[2][2];
    const char* cA = (const char*)g.A + (size_t)cur.pm * tstepA; const char* cB = (const char*)g.Bt + (size_t)cur.pn * tstepB;
    if constexpr (SP2) {
        PG8_STAGE(PG8_SB(0, 0), cB, voffB); PG8_STAGE(PG8_SB(0, 1), cB + hstepB, voffB); PG8_STAGE(PG8_SA(0, 0), cA, voffA); PG8_STAGE(PG8_SA(0, 1), cA + hstepA, voffA);
        if (wr == 1) PG8_BAR;
        PG8_WAIT_V(2); PG8_BAR;
        PG8_STAGE(PG8_SB(1, 0), cB + kstep, voffB); PG8_STAGE(PG8_SA(1, 0), cA + kstep, voffA); PG8_STAGE(PG8_SB(1, 1), cB + hstepB + kstep, voffB);
        PG8_WAIT_V(6); PG8_BAR;
    } else {
        PG8_STAGE(PG8_SB(0, 0), cB, voffB); PG8_STAGE(PG8_SA(0, 0), cA, voffA); PG8_STAGE(PG8_SB(0, 1), cB + hstepB, voffB); PG8_STAGE(PG8_SA(0, 1), cA + hstepA, voffA);
        if (wr == 1) PG8_BAR;
        PG8_WAIT_V(4); PG8_BAR;
        PG8_STAGE(PG8_SB(1, 0), cB + kstep, voffB); PG8_STAGE(PG8_SA(1, 0), cA + kstep, voffA); PG8_STAGE(PG8_SB(1, 1), cB + hstepB + kstep, voffB);
        PG8_WAIT_V(6); PG8_BAR;
    }
    for (;;) {
        const bool has_next = S.next(ui + 1, nxt);
        const char* nA = has_next ? (const char*)g.A + (size_t)nxt.pm * tstepA : cA; const char* nB = has_next ? (const char*)g.Bt + (size_t)nxt.pn * tstepB : cB;
        for (int t = 0; t < nt; t += 2) {
            const bool last = (t == nt - 2);
            const char* a1 = cA + (size_t)(t + 1) * kstep;
            const char* a2 = last ? nA : cA + (size_t)(t + 2) * kstep; const char* b2 = last ? nB : cB + (size_t)(t + 2) * kstep;
            const char* a3 = a2 + kstep; const char* b3 = b2 + kstep;
            if constexpr (SP2) {
            PG8_LDB(B0, 0, 0); PG8_LDB(B1, 0, 1); PG8_SCHED; PG8_LDA(At, 0, 0); PG8_STAGE(PG8_SA(1, 1), a1 + hstepA, voffA);
            PG8_WAIT_V(8); PG8_WAIT_L(0); PG8_BAR; PG8_MMA(0, 0, At, B0); PG8_MMA(0, 1, At, B1); PG8_BAR; PG8_SCHED;
            PG8_LDA(At, 0, 1); PG8_STAGE(PG8_SB(0, 0), b2, voffB); PG8_STAGE(PG8_SB(0, 1), b2 + hstepB, voffB); PG8_STAGE(PG8_SA(0, 0), a2, voffA);
            PG8_WAIT_V(8); PG8_WAIT_L(0); PG8_BAR; PG8_MMA(1, 0, At, B0); PG8_MMA(1, 1, At, B1); PG8_BAR; PG8_SCHED;
            PG8_LDB(B0, 1, 0); PG8_LDB(B1, 1, 1); PG8_SCHED; PG8_LDA(At, 1, 0); PG8_STAGE(PG8_SA(0, 1), a2 + hstepA, voffA);
            PG8_WAIT_V(8); PG8_WAIT_L(0); PG8_BAR; PG8_MMA(0, 0, At, B0); PG8_MMA(0, 1, At, B1); PG8_BAR; PG8_SCHED;
            PG8_LDA(At, 1, 1); PG8_STAGE(PG8_SB(1, 0), b3, voffB); PG8_STAGE(PG8_SB(1, 1), b3 + hstepB, voffB); PG8_STAGE(PG8_SA(1, 0), a3, voffA);
            PG8_WAIT_V(8); PG8_WAIT_L(0); PG8_BAR; PG8_MMA(1, 0, At, B0); PG8_MMA(1, 1, At, B1); PG8_BAR; PG8_SCHED;
            } else {
            PG8_LDB(B0, 0, 0); PG8_SCHED; PG8_LDA(At, 0, 0); PG8_STAGE(PG8_SA(1, 1), a1 + hstepA, voffA);
            PG8_WAIT_L(8); PG8_BAR; PG8_WAIT_L(0); PG8_MMA(0, 0, At, B0); PG8_BAR; PG8_SCHED;
            PG8_LDB(B1, 0, 1); PG8_STAGE(PG8_SB(0, 0), b2, voffB);
            PG8_BAR; PG8_WAIT_L(0); PG8_MMA(0, 1, At, B1); PG8_BAR;
            PG8_LDA(At, 0, 1); PG8_STAGE(PG8_SA(0, 0), a2, voffA);
            PG8_BAR; PG8_WAIT_L(0); PG8_MMA(1, 0, At, B0); PG8_BAR; PG8_SCHED;
            PG8_STAGE(PG8_SB(0, 1), b2 + hstepB, voffB);
            PG8_WAIT_V(6); PG8_BAR; PG8_MMA(1, 1, At, B1); PG8_BAR;
            PG8_LDB(B0, 1, 0); PG8_SCHED; PG8_LDA(At, 1, 0); PG8_STAGE(PG8_SA(0, 1), a2 + hstepA, voffA);
            PG8_WAIT_L(8); PG8_BAR; PG8_WAIT_L(0); PG8_MMA(0, 0, At, B0); PG8_BAR; PG8_SCHED;
            PG8_LDB(B1, 1, 1); PG8_STAGE(PG8_SB(1, 0), b3, voffB);
            PG8_BAR; PG8_WAIT_L(0); PG8_MMA(0, 1, At, B1); PG8_BAR;
            PG8_LDA(At, 1, 1); PG8_STAGE(PG8_SA(1, 0), a3, voffA);
            PG8_BAR; PG8_WAIT_L(0); PG8_MMA(1, 0, At, B0); PG8_BAR; PG8_SCHED;
            PG8_STAGE(PG8_SB(1, 1), b3 + hstepB, voffB);
            PG8_WAIT_V(6); PG8_BAR; PG8_MMA(1, 1, At, B1); PG8_BAR;
            }
        }
        if constexpr (ALIGN_EPI) { if (wr == 0) PG8_BAR; }
        E(acc, cur, wr, wc, fr, fq);
        if (!has_next) break;
#pragma unroll
        for (int a = 0; a < 2; ++a)
#pragma unroll
            for (int b = 0; b < 2; ++b)
#pragma unroll
                for (int m = 0; m < 4; ++m)
#pragma unroll
                    for (int n = 0; n < 2; ++n) acc[a][b][m][n] = (f32x4){0.f, 0.f, 0.f, 0.f};
        cur = nxt; cA = nA; cB = nB; ++ui;
        if constexpr (ALIGN_EPI) { if (wr == 1) PG8_BAR; }
    }
    PG8_WAIT_V(0);
    if constexpr (!ALIGN_EPI) { if (wr == 0) PG8_BAR; }
    PG8_BAR;
#undef PG8_SA
#undef PG8_SB
#undef PG8_STAGE
#undef PG8_LDA
#undef PG8_LDB
#undef PG8_MMA
#undef PG8_WAIT_V
#undef PG8_WAIT_L
#undef PG8_BAR
#undef PG8_SCHED
}

typedef f32x4 AccT[2][2][4][2];
struct EpiP {
    static constexpr bool PERM = true;
    bf16_t* P; bf16_t* PC;
    __device__ __forceinline__ void operator()(const AccT& acc, const Unit& u, int wr, int wc, int fr, int fq) const {
        const int col0 = u.pn * BM + wc * 32 + 8 * fq;
#pragma unroll
        for (int ai = 0; ai < 2; ++ai)
#pragma unroll
            for (int m = 0; m < 4; ++m) {
                const int row = u.pm * BM + ai * HALF + wr * 64 + m * 16 + fr;
                bf16_t* rp = (row < NTOK) ? P + (size_t)row * LDP : PC + (size_t)(row - NTOK) * LDP;
#pragma unroll
                for (int bj = 0; bj < 2; ++bj) { const int col = col0 + bj * HALF;
                    if (col < LDP) { u32x4 o; o.x = pk2(acc[ai][bj][m][0][0], acc[ai][bj][m][0][1]); o.y = pk2(acc[ai][bj][m][0][2], acc[ai][bj][m][0][3]);
                        o.z = pk2(acc[ai][bj][m][1][0], acc[ai][bj][m][1][1]); o.w = pk2(acc[ai][bj][m][1][2], acc[ai][bj][m][1][3]); *(u32x4*)(rp + col) = o; } }
            }
    }
};
template <int SECOND> struct EpiU {
    static constexpr bool PERM = true;
    const bf16_t* P; bf16_t* U; int gcol;
    __device__ __forceinline__ void operator()(const AccT& acc, const Unit& u, int wr, int wc, int fr, int fq) const {
        const int col0 = u.pn * BM + wc * 32 + 8 * fq;
#pragma unroll
        for (int ai = 0; ai < 2; ++ai)
#pragma unroll
            for (int m = 0; m < 4; ++m) {
                const int row = u.pm * BM + ai * HALF + wr * 64 + m * 16 + fr;
#pragma unroll
                for (int bj = 0; bj < 2; ++bj) { const int col = col0 + bj * HALF;
                    const u32x4 gv = *(const u32x4*)(P + (size_t)row * LDP + gcol + col); float gf[8]; unpack8(gv, gf);
                    float o[8];
#pragma unroll
                    for (int j = 0; j < 8; ++j) o[j] = sigmoidf_(gf[j]) * acc[ai][bj][m][j >> 2][j & 3];
                    bf16_t* up = U + (size_t)row * DM + col;
                    if (SECOND) { const u32x4 pv = *(const u32x4*)up; float pf[8]; unpack8(pv, pf);
#pragma unroll
                        for (int j = 0; j < 8; ++j) o[j] += pf[j]; }
                    *(u32x4*)up = pack8(o); }
            }
    }
};
struct EpiX1 {
    static constexpr bool PERM = true;
    const float* x; const float* mod; float* x1; float* rowsq;
    __device__ __forceinline__ void operator()(const AccT& acc, const Unit& u, int wr, int wc, int fr, int fq) const {
        const int col0 = u.pn * BM + wc * 32 + 8 * fq;
#pragma unroll
        for (int ai = 0; ai < 2; ++ai)
#pragma unroll
            for (int m = 0; m < 4; ++m) {
                const int row = u.pm * BM + ai * HALF + wr * 64 + m * 16 + fr; const int b = row >> 13;
                float ss = 0.f;
#pragma unroll
                for (int bj = 0; bj < 2; ++bj) { const int col = col0 + bj * HALF;
                    const float* xp = x + (size_t)row * DM + col; const float* gp = mod + b * 12288 + 2 * DM + col;
#pragma unroll
                    for (int n = 0; n < 2; ++n) { const f32x4 xv = *(const f32x4*)(xp + 4 * n); const f32x4 gv = *(const f32x4*)(gp + 4 * n);
                        f32x4 o = xv + gv * acc[ai][bj][m][n]; *(f32x4*)(x1 + (size_t)row * DM + col + 4 * n) = o;
                        ss += o[0] * o[0] + o[1] * o[1] + o[2] * o[2] + o[3] * o[3]; } }
                ss += __shfl_xor(ss, 16); ss += __shfl_xor(ss, 32);
                if (fq == 0) rowsq[(size_t)(u.pn * 4 + wc) * NTOK + row] = ss;
            }
    }
};
struct EpiQ {
    static constexpr bool PERM = true;
    bf16_t* O;
    __device__ __forceinline__ void operator()(const AccT& acc, const Unit& u, int wr, int wc, int fr, int fq) const {
        const int col0 = u.pn * BM + wc * 32 + 8 * fq;
#pragma unroll
        for (int ai = 0; ai < 2; ++ai)
#pragma unroll
            for (int m = 0; m < 4; ++m) {
                const int row = u.pm * BM + ai * HALF + wr * 64 + m * 16 + fr;
#pragma unroll
                for (int bj = 0; bj < 2; ++bj) { const int col = col0 + bj * HALF; u32x4 o;
                    o.x = pk2(acc[ai][bj][m][0][0], acc[ai][bj][m][0][1]); o.y = pk2(acc[ai][bj][m][0][2], acc[ai][bj][m][0][3]);
                    o.z = pk2(acc[ai][bj][m][1][0], acc[ai][bj][m][1][1]); o.w = pk2(acc[ai][bj][m][1][2], acc[ai][bj][m][1][3]);
                    *(u32x4*)(O + (size_t)row * DM + col) = o; }
            }
    }
};
}

#define XB_TMO      128
#define XB_XCNT(j)  (256  + 64 * (j))
#define XB_XSUB(j)  (1280 + 64 * (j))
#define XB_XGEN(j)  (2304 + 64 * (j))
#define XB_TOP      3328
#define XB_TOPGEN   3392
#define XCD_BAR_WORDS 3456
#define XB_SPIN_CAP (1u << 20)
__device__ __forceinline__ unsigned xb_ld(unsigned* p)              { return __hip_atomic_load(p, __ATOMIC_RELAXED, __HIP_MEMORY_SCOPE_AGENT); }
__device__ __forceinline__ unsigned xb_add(unsigned* p, unsigned v) { return __hip_atomic_fetch_add(p, v, __ATOMIC_RELAXED, __HIP_MEMORY_SCOPE_AGENT); }
__device__ __forceinline__ unsigned xb_xcc_id() { return (unsigned)__builtin_amdgcn_s_getreg((3 << 11) | 20) & 0xFu; }
#define XB_SPIN(cond, bar) do { unsigned _sp = 0; while (cond) { __builtin_amdgcn_s_sleep(1); \
    if ((++_sp & 255u) == 0u) { if (xb_ld(&(bar)[XB_TMO])) break; if (_sp > XB_SPIN_CAP) { atomicAdd(&(bar)[XB_TMO], 1u); break; } } } } while (0)
struct XcdBarrier { unsigned* bar; unsigned x; volatile LAS unsigned* st; };
__device__ __forceinline__ XcdBarrier xcd_barrier_post(unsigned* bar, volatile LAS unsigned* st) {
    XcdBarrier b; b.bar = bar; b.x = xb_xcc_id(); b.st = st;
    if (threadIdx.x == 0) (void)xb_add(&bar[XB_XCNT(b.x)], 1u);
    return b;
}
__device__ __forceinline__ void xcd_barrier_complete(unsigned* bar, unsigned x, unsigned& nloc, unsigned& nx) {
    const unsigned G = gridDim.x * gridDim.y * gridDim.z;
    unsigned sum, cnt, mine, sp = 0u;
    for (;;) {
        sum = 0u; cnt = 0u; mine = 0u;
#pragma unroll
        for (unsigned j = 0; j < 16; ++j) { const unsigned c = xb_ld(&bar[XB_XCNT(j)]); sum += c; cnt += (c > 0u) ? 1u : 0u; mine = (j == x) ? c : mine; }
        if (sum == G) break;
        __builtin_amdgcn_s_sleep(1);
        if ((++sp & 255u) == 0u) { if (xb_ld(&bar[XB_TMO])) break; if (sp > XB_SPIN_CAP) { atomicAdd(&bar[XB_TMO], 1u); break; } }
    }
    nloc = mine > 0u ? mine : 1u; nx = cnt > 0u ? cnt : 1u;
}
__device__ __forceinline__ void xcd_barrier(const XcdBarrier& b) {
    asm volatile("s_waitcnt vmcnt(0)" ::: "memory");
    __syncthreads();
    if (threadIdx.x == 0) {
        unsigned* bar = b.bar;
        __builtin_amdgcn_s_waitcnt(0);
        unsigned nloc = b.st[0], nx = b.st[1];
        if (nloc == 0u) { xcd_barrier_complete(bar, b.x, nloc, nx); b.st[0] = nloc; b.st[1] = nx; }
        const unsigned old = xb_add(&bar[XB_XSUB(b.x)], 1u);
        const unsigned gen = old / nloc;
        if (old + 1u == (gen + 1u) * nloc) {
            __builtin_amdgcn_fence(__ATOMIC_RELEASE, "agent");
            asm volatile("s_waitcnt vmcnt(0)" ::: "memory");
            const unsigned og = xb_add(&bar[XB_TOP], 1u);
            const unsigned tg = og / nx;
            if (og + 1u == (tg + 1u) * nx) xb_add(&bar[XB_TOPGEN], 1u);
            else XB_SPIN(xb_ld(&bar[XB_TOPGEN]) == tg, bar);
            __builtin_amdgcn_fence(__ATOMIC_ACQUIRE, "agent");
            xb_add(&bar[XB_XGEN(b.x)], 1u);
            asm volatile("s_waitcnt vmcnt(0)" ::: "memory");
        } else {
            XB_SPIN(xb_ld(&bar[XB_XGEN(b.x)]) == gen, bar);
            __builtin_amdgcn_fence(__ATOMIC_ACQUIRE, "agent");
            asm volatile("s_waitcnt vmcnt(0)" ::: "memory");
        }
    }
    __syncthreads();
}

template <int MB, int NBK>
__device__ __forceinline__ void wave_mma(f32x4 (&acc)[MB][NBK], const LAS unsigned char* A, int lda_b, const LAS unsigned char* Bt, int ldb_b, int K, int lane) {
    const int r = lane & 15, q = lane >> 4;
    const LAS unsigned char* ap = A + r * lda_b + q * 16;
    const LAS unsigned char* bp = Bt + r * ldb_b + q * 16;
#pragma unroll 1
    for (int k0 = 0; k0 < K; k0 += 32) {
        bf16x8 a[MB];
#pragma unroll
        for (int mb = 0; mb < MB; ++mb) a[mb] = *(const LAS bf16x8*)(ap + mb * 16 * lda_b + k0 * 2);
#pragma unroll
        for (int nb = 0; nb < NBK; ++nb) { const bf16x8 b = *(const LAS bf16x8*)(bp + nb * 16 * ldb_b + k0 * 2);
#pragma unroll
            for (int mb = 0; mb < MB; ++mb) acc[mb][nb] = __builtin_amdgcn_mfma_f32_16x16x32_bf16(a[mb], b, acc[mb][nb], 0, 0, 0); }
    }
}

struct Args { const float* in[20]; float* out; unsigned char* ws; int ph_lo, ph_hi; };

#define IN_X 0
#define IN_C 1
#define IN_CTX 2
#define IN_CCTX 3
#define IN_WADA 4
#define IN_BADA 5
#define IN_N1G 6
#define IN_WIN 7
#define IN_RDEC 8
#define IN_MCONV 9
#define IN_MGB 10
#define IN_WRO 11
#define IN_WMO 12
#define IN_WO 13
#define IN_N2G 14
#define IN_PQ 15
#define IN_PK 16
#define IN_PD 17
#define IN_PU 18
#define IN_FG 19

template <int MODE>
__device__ __forceinline__ void transpose_item(const float* W, int K, int N, int Npad, bf16_t* WT, LAS float* scr, int item, int lane) {
    const int nblk = Npad / 32, kb = item / nblk, nb = item % nblk, k0 = 64 * kb, n0 = 32 * nb;
    const int n = n0 + (lane & 31);
    int src = n;
    if (MODE == 1) { src = (n < 6144) ? n : (n < 10240 ? n + 16 : (n < 10256 ? n - 10240 + 6144 : -1)); }
#pragma unroll 8
    for (int i = 0; i < 32; ++i) { const int kk = 2 * i + (lane >> 5); scr[kk * 33 + (lane & 31)] = (src >= 0) ? W[(size_t)(k0 + kk) * N + src] : 0.f; }
    LDS_WAIT(); asm volatile("" ::: "memory");
    const int c = lane & 7;
#pragma unroll
    for (int j = 0; j < 4; ++j) { const int nn = (lane >> 3) + 8 * j; const LAS float* s = scr + (8 * c) * 33 + nn;
        u32x4 o; o.x = pk2(s[0 * 33], s[1 * 33]); o.y = pk2(s[2 * 33], s[3 * 33]); o.z = pk2(s[4 * 33], s[5 * 33]); o.w = pk2(s[6 * 33], s[7 * 33]);
        *(u32x4*)(WT + (size_t)(n0 + nn) * K + k0 + 8 * c) = o; }
    LDS_WAIT(); asm volatile("" ::: "memory");
}

__device__ __forceinline__ u32x4 ld16(const bf16_t* p) { return *(const u32x4*)p; }
__device__ __forceinline__ void conv8(const bf16_t* base  , int t, int Ls, const float* w0, const float* w1, const float* w2, float* out) {
    float c[8], p[8], n[8];
    unpack8(ld16(base + (size_t)t * LDP), c);
    if (t > 0) unpack8(ld16(base + (size_t)(t - 1) * LDP), p); else { for (int j = 0; j < 8; ++j) p[j] = 0.f; }
    if (t < Ls - 1) unpack8(ld16(base + (size_t)(t + 1) * LDP), n); else { for (int j = 0; j < 8; ++j) n[j] = 0.f; }
#pragma unroll
    for (int j = 0; j < 8; ++j) { const float pre = w0[j] * p[j] + w1[j] * c[j] + w2[j] * n[j]; out[j] = pre * sigmoidf_(pre); }
}
__device__ __forceinline__ void conv8r(const u32x4 rp, const u32x4 rc, const u32x4 rn, const float* w0, const float* w1, const float* w2, float* out) {
    float c[8], p[8], n[8]; unpack8(rc, c); unpack8(rp, p); unpack8(rn, n);
#pragma unroll
    for (int j = 0; j < 8; ++j) { const float pre = w0[j] * p[j] + w1[j] * c[j] + w2[j] * n[j]; out[j] = pre * sigmoidf_(pre); }
}
__device__ __forceinline__ void conv_rows(const bf16_t* base, int t0, int s0, int Ls, u32x4 (&rows)[4][3]) {
    const u32x4 z = {0u, 0u, 0u, 0u};
#pragma unroll
    for (int i = 0; i < 4; ++i) { const int t = t0 + s0 + 32 * i;
        rows[i][1] = ld16(base + (size_t)t * LDP);
        rows[i][0] = (t > 0) ? ld16(base + (size_t)(t - 1) * LDP) : z;
        rows[i][2] = (t < Ls - 1) ? ld16(base + (size_t)(t + 1) * LDP) : z; }
}
__device__ __forceinline__ void ldw8(const float* p, float* w) { const f32x4 a = *(const f32x4*)p, b = *(const f32x4*)(p + 4); w[0] = a[0]; w[1] = a[1]; w[2] = a[2]; w[3] = a[3]; w[4] = b[0]; w[5] = b[1]; w[6] = b[2]; w[7] = b[3]; }

__device__ __forceinline__ void scan128_sum_prefix(float& lo, float& hi, int lane) {
#pragma unroll
    for (int o = 1; o < 64; o <<= 1) { const float a = __shfl_up(lo, o), b = __shfl_up(hi, o); if (lane >= o) { lo += a; hi += b; } }
    hi += __shfl(lo, 63);
}
__device__ __forceinline__ void scan128_sum_suffix(float& lo, float& hi, int lane) {
#pragma unroll
    for (int o = 1; o < 64; o <<= 1) { const float a = __shfl_down(lo, o), b = __shfl_down(hi, o); if (lane + o < 64) { lo += a; hi += b; } }
    lo += __shfl(hi, 0);
}
__device__ __forceinline__ void scan128_max_prefix(float& lo, float& hi, int lane) {
#pragma unroll
    for (int o = 1; o < 64; o <<= 1) { const float a = __shfl_up(lo, o), b = __shfl_up(hi, o); if (lane >= o) { lo = fmaxf(lo, a); hi = fmaxf(hi, b); } }
    hi = fmaxf(hi, __shfl(lo, 63));
}
__device__ __forceinline__ void scan128_max_suffix(float& lo, float& hi, int lane) {
#pragma unroll
    for (int o = 1; o < 64; o <<= 1) { const float a = __shfl_down(lo, o), b = __shfl_down(hi, o); if (lane + o < 64) { lo = fmaxf(lo, a); hi = fmaxf(hi, b); } }
    lo = fmaxf(lo, __shfl(hi, 0));
}

__device__ __forceinline__ float gelu_erf(float v) { return 0.5f * v * (1.f + erff(v * 0.70710678118654752f)); }

__device__ __forceinline__ float fmix_lo(float w, unsigned h2, float acc) { asm("v_fma_mix_f32 %0, %1, %2, %0 op_sel:[0,0,0] op_sel_hi:[0,1,0]" : "+v"(acc) : "v"(w), "v"(h2)); return acc; }
__device__ __forceinline__ float fmix_hi(float w, unsigned h2, float acc) { asm("v_fma_mix_f32 %0, %1, %2, %0 op_sel:[0,1,0] op_sel_hi:[0,1,0]" : "+v"(acc) : "v"(w), "v"(h2)); return acc; }
#define EBLK(e) ((((unsigned)(e) >> 7) ^ (unsigned)(e)) & 15u)
#define EROWIN(e) ((((unsigned)(e) >> 7) << 3) | (((unsigned)(e) & 127u) >> 4))
#define EROW(ebv, r) ((((r) >> 3) << 7) + (((r) & 7) << 4) + ((((ebv) ^ ((r) >> 3))) & 15))
__device__ __forceinline__ void ins16(float (&L)[16], float x) {
#pragma unroll
    for (int j = 15; j >= 1; --j) L[j] = __builtin_amdgcn_fmed3f(L[j - 1], L[j], x);
    L[0] = fmaxf(L[0], x);
}

__global__ void __launch_bounds__(NTHR, 2) fwd_kernel(Args args) {
    extern __shared__ __attribute__((aligned(16))) unsigned char lds_raw[];
    LAS unsigned char* lds = (LAS unsigned char*)lds_raw;
    const int tid = threadIdx.x, lane = tid & 63, wave = __builtin_amdgcn_readfirstlane(tid >> 6);
    const int G = gridDim.x, bx = blockIdx.x;
    const int gw = bx * NWAVES + wave, NGW = G * NWAVES;
    const int gt = bx * NTHR + tid, NGT = G * NTHR;
    unsigned char* ws = args.ws;
    const int lo = args.ph_lo, hi = args.ph_hi;

    volatile LAS unsigned* MISC = (volatile LAS unsigned*)(lds + LDS_MISC);
    XcdBarrier bar; bar.bar = (unsigned*)(ws + WS_CTL); bar.x = 0; bar.st = MISC;
    const bool fused = (hi - lo) > 1;
    if (fused) {
        if (tid < 4) MISC[tid] = 0u;
        __syncthreads();
        bar = xcd_barrier_post((unsigned*)(ws + WS_CTL), MISC);
    }
#ifndef PH_MASK
#define PH_MASK 0x7FFF
#endif
#define IN(k) (((PH_MASK >> (k)) & 1) && lo <= (k) && (k) < hi)
#ifndef REPEAT_MASK
#define REPEAT_MASK 0
#endif
#define NREP(k) ((((REPEAT_MASK) >> (k)) & 1) ? 2 : 1)
#ifndef VAR_NODMA
#define VAR_NODMA 0
#endif
#ifndef VAR_NOCOMP
#define VAR_NOCOMP 0
#endif
#ifndef VAR_NOAUX
#define VAR_NOAUX 0
#endif
#define VARON(k, f) ((f) && NREP(k) == 2 && rep_ == 0)
#define SEAM(k) do { if (IN(k) && IN((k) + 1)) { if ((k) == 0) { cg::this_grid().sync(); } else { xcd_barrier(bar); } } } while (0)

    float* MOD = (float*)(ws + WS_MOD);
    float* ROTC = (float*)(ws + WS_ROTC); float* ROTS = (float*)(ws + WS_ROTS);
    bf16_t* P = (bf16_t*)(ws + WS_P); bf16_t* PC = (bf16_t*)(ws + WS_PCTX);

    for (int rep_ = 0; rep_ < NREP(0); ++rep_) { if (rep_) xcd_barrier(bar);
    if (IN(0)) {
        const float* c = args.in[IN_C]; const float* cctx = args.in[IN_CCTX]; const float* wada = args.in[IN_WADA]; const float* bada = args.in[IN_BADA];
        LAS float* sc = (LAS float*)lds;
        LAS float* red = (LAS float*)(lds + 40960);
        if (bx < 192) {
            for (int i = tid; i < 5 * DM; i += NTHR) { const float v = (i < 4 * DM) ? c[i] : cctx[i - 4 * DM]; sc[i] = v * sigmoidf_(v); }
            __syncthreads();
        }
        for (int u = bx; u < 192; u += G) {
            const int rg = tid >> 4, cq = tid & 15;
            f32x4 acc[5];
#pragma unroll
            for (int r = 0; r < 5; ++r) acc[r] = (f32x4){0.f, 0.f, 0.f, 0.f};
            for (int k = rg; k < DM; k += 32) { const f32x4 w = *(const f32x4*)(wada + (size_t)k * 12288 + 64 * u + 4 * cq);
#pragma unroll
                for (int r = 0; r < 5; ++r) acc[r] += w * sc[r * DM + k]; }
#pragma unroll
            for (int r = 0; r < 5; ++r)
#pragma unroll
                for (int j = 0; j < 4; ++j) red[(rg * 5 + r) * 64 + 4 * cq + j] = acc[r][j];
            __syncthreads();
            if (tid < 320) { const int r = tid >> 6, j = tid & 63; float s = bada[64 * u + j];
                for (int g2 = 0; g2 < 32; ++g2) s += red[(g2 * 5 + r) * 64 + j];
                MOD[r * 12288 + 64 * u + j] = s; }
            __syncthreads();
        }
        __syncthreads();
        LAS float* scr = (LAS float*)(lds + wave * 16384);
        constexpr int I_IN = 32 * (NPADW / 32), I_RO = 16 * 64, I_O = 32 * 64;
        constexpr int NITEMS = I_IN + 2 * I_RO + 2 * I_O;
        for (int it = gw; it < NITEMS; it += NGW) {
            int r = it;
            if (r < I_IN) { transpose_item<1>(args.in[IN_WIN], DM, LDP, NPADW, (bf16_t*)(ws + WS_WINT), scr, r, lane); continue; } r -= I_IN;
            if (r < I_RO) { transpose_item<0>(args.in[IN_WRO], 1024, DM, DM, (bf16_t*)(ws + WS_WRO), scr, r, lane); continue; } r -= I_RO;
            if (r < I_RO) { transpose_item<0>(args.in[IN_WMO], 1024, DM, DM, (bf16_t*)(ws + WS_WMO), scr, r, lane); continue; } r -= I_RO;
            if (r < I_O) { transpose_item<0>(args.in[IN_WO], DM, DM, DM, (bf16_t*)(ws + WS_WO), scr, r, lane); continue; } r -= I_O;
            transpose_item<0>(args.in[IN_PQ], DM, DM, DM, (bf16_t*)(ws + WS_WQ), scr, r, lane);
        }
        { const float* pk = args.in[IN_PK]; bf16_t* k16 = (bf16_t*)(ws + WS_KEYS);
          for (int i = gt; i < 262144 / 8; i += NGT) { const f32x4 a = *(const f32x4*)(pk + (size_t)i * 8), b = *(const f32x4*)(pk + (size_t)i * 8 + 4);
              u32x4 o; o.x = pk2(a[0], a[1]); o.y = pk2(a[2], a[3]); o.z = pk2(b[0], b[1]); o.w = pk2(b[2], b[3]); *(u32x4*)(k16 + (size_t)i * 8) = o; } }
        for (int i = gt; i < SEQ * 32; i += NGT) { const int t = i >> 5, ii = i & 31, a = ii & 15;
            const float freq = powf(10000.f, -(float)a / 16.f); const float pos = (ii < 16) ? (float)(t >> 6) : (float)(t & 63); const float ang = pos * freq;
            ROTC[i] = cosf(ang); ROTS[i] = sinf(ang); }
    }
    }
    SEAM(0);

    for (int rep_ = 0; rep_ < NREP(1); ++rep_) { if (rep_) xcd_barrier(bar);
    if (IN(1)) {
        const float* x = args.in[IN_X]; const float* ctx = args.in[IN_CTX]; const float* g1 = args.in[IN_N1G]; bf16_t* H1 = (bf16_t*)(ws + WS_H1);
        for (int row = gw; row < MROWS; row += NGW) {
            const float* src = (row < NTOK) ? x + (size_t)row * DM : ctx + (size_t)(row - NTOK) * DM; const int r = (row < NTOK) ? (row >> 13) : 4;
            f32x4 v[8]; float ss = 0.f;
#pragma unroll
            for (int j = 0; j < 8; ++j) { v[j] = *(const f32x4*)(src + 4 * (lane + 64 * j)); ss += v[j][0] * v[j][0] + v[j][1] * v[j][1] + v[j][2] * v[j][2] + v[j][3] * v[j][3]; }
            const float rstd = rsqrtf(wave_sum(ss) * (1.f / DM) + 1e-6f);
            const float* shp = MOD + r * 12288; const float* scp = shp + DM;
#pragma unroll
            for (int j = 0; j < 8; ++j) { const int idx = 4 * (lane + 64 * j); const f32x4 g = *(const f32x4*)(g1 + idx), sh = *(const f32x4*)(shp + idx), sc = *(const f32x4*)(scp + idx);
                const f32x4 h = v[j] * rstd * g * (sc + 1.f) + sh; u32x2 o; o.x = pk2(h[0], h[1]); o.y = pk2(h[2], h[3]); *(u32x2*)(H1 + (size_t)row * DM + idx) = o; }
        }
    }
    }
    SEAM(1);

    for (int rep_ = 0; rep_ < NREP(2); ++rep_) { if (rep_) xcd_barrier(bar);
    if (IN(2)) {
        pg8::Gemm g{(const bf16_t*)(ws + WS_H1), (const bf16_t*)(ws + WS_WINT), DM, DM}; pg8::OrderG1 S{G, bx}; pg8::EpiP E{P, PC};
        pg8::gemm_phase<pg8::EpiP, pg8::OrderG1>(lds, g, S, E);
    }
    }
    SEAM(2);

    const float* rdec = args.in[IN_RDEC]; const float* mconv = args.in[IN_MCONV]; const float* mgb = args.in[IN_MGB];
    bf16_t* RST = (bf16_t*)(ws + WS_RST); bf16_t* MST = (bf16_t*)(ws + WS_MST);
    float* MSCAL = (float*)(ws + WS_MSCAL); float* MPREV = (float*)(ws + WS_MPREV); float* NLOC = (float*)(ws + WS_NLOC); float* NPREV = (float*)(ws + WS_NPREV);

    for (int rep_ = 0; rep_ < NREP(3); ++rep_) { if (rep_) xcd_barrier(bar);
    if (IN(3)) {
        for (int u = bx; u < 1056 + 2112; u += G) {
            int tid = threadIdx.x; asm volatile("" : "+v"(tid)); const int lane = tid & 63;
            if (u < 1056) {
                const int bh = u / 66, cc = u % 66, b = bh >> 2, h = bh & 3;
                const bool ctxu = cc >= 64; const int Ls = ctxu ? CTXL : SEQ; const int t0 = ctxu ? (cc - 64) * 128 : cc * 128;
                const bf16_t* Pb = ctxu ? PC + (size_t)(b * CTXL) * LDP : P + (size_t)(b * SEQ) * LDP;
                LAS unsigned char* KWT = lds;
                LAS unsigned char* VT = lds + 69632;
                LAS float* WTS = (LAS float*)(lds + 104448);
                if (wave < 2) {
                    const int dir = wave;
                    const float bi = mgb[dir * 8 + h], bfv = mgb[dir * 8 + 4 + h];
                    const bf16_t* gp = Pb + (size_t)t0 * LDP + C_MG + dir * 8 + h;
                    const float i_lo = bf2f(gp[(size_t)lane * LDP]) + bi, i_hi = bf2f(gp[(size_t)(lane + 64) * LDP]) + bi;
                    const float f_lo = logsigf_(bf2f(gp[(size_t)lane * LDP + 4]) + bfv), f_hi = logsigf_(bf2f(gp[(size_t)(lane + 64) * LDP + 4]) + bfv);
                    float c_lo = f_lo, c_hi = f_hi, bend;
                    if (dir == 0) { scan128_sum_prefix(c_lo, c_hi, lane); bend = __shfl(c_hi, 63); }
                    else { scan128_sum_suffix(c_lo, c_hi, lane); bend = __shfl(c_lo, 0); }
                    const float w_lo = bend - c_lo + i_lo, w_hi = bend - c_hi + i_hi;
                    const float M = wave_max(fmaxf(w_lo, w_hi));
                    WTS[dir * 128 + lane] = __expf(w_lo - M); WTS[dir * 128 + 64 + lane] = __expf(w_hi - M);
                    if (lane == 0) { MSCAL[((dir * 16 + bh) * 66 + cc) * 2] = M; MSCAL[((dir * 16 + bh) * 66 + cc) * 2 + 1] = bend; }
                }
                __syncthreads();
                {   const int ch = (tid >> 5) * 8, s0 = tid & 31;
                    float w0[8], w1[8], w2[8]; const float* wp = mconv + 512 + h * 128 + ch; ldw8(wp, w0); ldw8(wp + 1024, w1); ldw8(wp + 2048, w2);
                    u32x4 rows[4][3]; conv_rows(Pb + C_MK + h * 128 + ch, t0, s0, Ls, rows);
#pragma unroll
                    for (int i = 0; i < 4; ++i) { const int s = s0 + 32 * i; float kv[8]; conv8r(rows[i][0], rows[i][1], rows[i][2], w0, w1, w2, kv);
                        const float wf = WTS[s] * 0.08838834764831845f, wb = WTS[128 + s] * 0.08838834764831845f;
#pragma unroll
                        for (int j = 0; j < 8; ++j) { *(LAS bf16_t*)(KWT + ((ch + j) * 136 + s) * 2) = f2bf(kv[j] * wf); *(LAS bf16_t*)(KWT + ((128 + ch + j) * 136 + s) * 2) = f2bf(kv[j] * wb); } } }
#pragma unroll 1
                for (int half = 0; half < 2; ++half) {
                    __syncthreads();
                    { u32x4 raw_[4];
#pragma unroll
                    for (int i = 0; i < 4; ++i) { const int task = tid + NTHR * i, s = task & 127, e8 = (task >> 7) * 8; raw_[i] = ld16(Pb + (size_t)(t0 + s) * LDP + C_MV + h * 256 + half * 128 + e8); }
#pragma unroll
                    for (int i = 0; i < 4; ++i) { const int task = tid + NTHR * i, s = task & 127, e8 = (task >> 7) * 8; const u32x4 v = raw_[i];
#pragma unroll
                        for (int j = 0; j < 4; ++j) { *(LAS bf16_t*)(VT + ((e8 + 2 * j) * 136 + s) * 2) = (bf16_t)(v[j] & 0xffffu); *(LAS bf16_t*)(VT + ((e8 + 2 * j + 1) * 136 + s) * 2) = (bf16_t)(v[j] >> 16); } } }
                    __syncthreads();
                    if (half == 0 && tid < 256) { float s = 0.f; const LAS bf16_t* rp = (const LAS bf16_t*)(KWT + tid * 272);
                        for (int k = 0; k < 128; ++k) s += bf2f(rp[k]);
                        NLOC[(((tid >> 7) * 16 + bh) * 66 + cc) * 128 + (tid & 127)] = s; }
                    f32x4 acc[2][8];
#pragma unroll
                    for (int a = 0; a < 2; ++a)
#pragma unroll
                        for (int n = 0; n < 8; ++n) acc[a][n] = (f32x4){0.f, 0.f, 0.f, 0.f};
                    {   f32x4 (&a0)[1][8] = *reinterpret_cast<f32x4 (*)[1][8]>(&acc[0]); f32x4 (&a1)[1][8] = *reinterpret_cast<f32x4 (*)[1][8]>(&acc[1]);
                        wave_mma<1, 8>(a0, KWT + (16 * wave) * 272, 272, VT, 272, 128, lane);
                        wave_mma<1, 8>(a1, KWT + (128 + 16 * wave) * 272, 272, VT, 272, 128, lane); }
                    const int r = lane & 15, q = lane >> 4;
#pragma unroll
                    for (int dir = 0; dir < 2; ++dir)
#pragma unroll
                        for (int nb = 0; nb < 8; ++nb) { const int e = half * 128 + nb * 16 + r, d = 16 * wave + q * 4;
                            u32x2 o; o.x = pk2(acc[dir][nb][0], acc[dir][nb][1]); o.y = pk2(acc[dir][nb][2], acc[dir][nb][3]);
                            *(u32x2*)(MST + ((size_t)((dir * 16 + bh) * 66 + cc) * 256 + e) * 128 + d) = o; }
                }
                __syncthreads();
            } else {
                const int v = u - 1056; const int bh = v / 66, cc = v % 66, b = bh >> 3, h = bh & 7;
                const bool ctxu = cc >= 64; const int t0 = ctxu ? (cc - 64) * 128 : cc * 128;
                const bf16_t* Pb = ctxu ? PC + (size_t)(b * CTXL) * LDP : P + (size_t)(b * SEQ) * LDP;
                LAS unsigned char* KT = lds;
                LAS unsigned char* VT = lds + 34816;
                const float lgf = logsigf_(rdec[h]), lgb = logsigf_(rdec[8 + h]);
                { u32x4 raw_[4];
#pragma unroll
                for (int i = 0; i < 4; ++i) { const int task = tid + NTHR * i, s = task & 127, e8 = (task >> 7) * 8; raw_[i] = ld16(Pb + (size_t)(t0 + s) * LDP + C_RV + h * 128 + e8); }
#pragma unroll
                for (int i = 0; i < 4; ++i) { const int task = tid + NTHR * i, s = task & 127, e8 = (task >> 7) * 8; const u32x4 vv = raw_[i];
#pragma unroll
                    for (int j = 0; j < 4; ++j) { *(LAS bf16_t*)(VT + ((e8 + 2 * j) * 136 + s) * 2) = (bf16_t)(vv[j] & 0xffffu); *(LAS bf16_t*)(VT + ((e8 + 2 * j + 1) * 136 + s) * 2) = (bf16_t)(vv[j] >> 16); } } }
                {   const int s = tid & 127, ic = (tid >> 7) * 8; float k1[8], k2[8];
                    const bf16_t* kp = Pb + (size_t)(t0 + s) * LDP + C_RK + h * 64 + ic; unpack8(ld16(kp), k1); unpack8(ld16(kp + 32), k2);
                    const float df = __expf(lgf * (float)(127 - s)) * 0.125f, db = __expf(lgb * (float)s) * 0.125f;
#pragma unroll
                    for (int j = 0; j < 8; ++j) { float r1 = k1[j], r2 = k2[j];
                        if (!ctxu) { const float cs = ROTC[(t0 + s) * 32 + ic + j], sn = ROTS[(t0 + s) * 32 + ic + j]; r1 = k1[j] * cs - k2[j] * sn; r2 = k2[j] * cs + k1[j] * sn; }
                        *(LAS bf16_t*)(KT + ((ic + j) * 136 + s) * 2) = f2bf(r1 * df); *(LAS bf16_t*)(KT + ((32 + ic + j) * 136 + s) * 2) = f2bf(r2 * df);
                        *(LAS bf16_t*)(KT + ((64 + ic + j) * 136 + s) * 2) = f2bf(r1 * db); *(LAS bf16_t*)(KT + ((96 + ic + j) * 136 + s) * 2) = f2bf(r2 * db); } }
                __syncthreads();
                f32x4 acc[1][8];
#pragma unroll
                for (int n = 0; n < 8; ++n) acc[0][n] = (f32x4){0.f, 0.f, 0.f, 0.f};
                wave_mma<1, 8>(acc, KT + (16 * wave) * 272, 272, VT, 272, 128, lane);
                const int r = lane & 15, q = lane >> 4, dir = wave >> 2, d = ((16 * wave) & 63) + q * 4;
#pragma unroll
                for (int nb = 0; nb < 8; ++nb) { const int e = nb * 16 + r; u32x2 o; o.x = pk2(acc[0][nb][0], acc[0][nb][1]); o.y = pk2(acc[0][nb][2], acc[0][nb][3]);
                    *(u32x2*)(RST + ((size_t)((dir * 32 + bh) * 66 + cc) * 128 + e) * 64 + d) = o; }
                __syncthreads();
            }
        }
    }
    }
    SEAM(3);

    for (int rep_ = 0; rep_ < NREP(4); ++rep_) { if (rep_) xcd_barrier(bar);
    if (IN(4)) {
        for (int task = gt; task < 65536; task += NGT) {
            const int dc = task & 7, e = (task >> 3) & 127, bh = (task >> 10) & 31, dir = task >> 15, h = bh & 7;
            const float g = expf(128.f * logsigf_(rdec[dir * 8 + h]));
            bf16_t* base = RST + (size_t)((dir * 32 + bh) * 66) * 8192 + e * 64 + dc * 8;
            float S[8], v[8];
#pragma unroll
            for (int j = 0; j < 8; ++j) S[j] = 0.f;
            for (int k = 0; k < 2; ++k) { const int cc = dir ? (65 - k) : (64 + k); unpack8(ld16(base + (size_t)cc * 8192), v);
#pragma unroll
                for (int j = 0; j < 8; ++j) S[j] = g * S[j] + v[j]; }
#pragma unroll 1
            for (int kb = 0; kb < 64; kb += 8) { u32x4 raw[8];
#pragma unroll
                for (int kk = 0; kk < 8; ++kk) { const int c = dir ? (63 - kb - kk) : (kb + kk); raw[kk] = ld16(base + (size_t)c * 8192); }
#pragma unroll
                for (int kk = 0; kk < 8; ++kk) { const int c = dir ? (63 - kb - kk) : (kb + kk); unpack8(raw[kk], v); *(u32x4*)(base + (size_t)c * 8192) = pack8(S);
#pragma unroll
                    for (int j = 0; j < 8; ++j) S[j] = g * S[j] + v[j]; } }
        }
        for (int task = gt; task < 131072; task += NGT) {
            const int dc = task & 15, e = (task >> 4) & 255, bh = (task >> 12) & 15, dir = task >> 16;
            bf16_t* base = MST + (size_t)((dir * 16 + bh) * 66) * 32768 + e * 128 + dc * 8;
            const float* scp = MSCAL + (size_t)((dir * 16 + bh) * 66) * 2;
            float S[8], v[8], m = 0.f;
#pragma unroll
            for (int j = 0; j < 8; ++j) S[j] = 0.f;
            for (int k = 0; k < 2; ++k) { const int cc = dir ? (65 - k) : (64 + k); unpack8(ld16(base + (size_t)cc * 32768), v);
                const float M = scp[cc * 2], be = scp[cc * 2 + 1], mn = fmaxf(be + m, M), cS = expf(be + m - mn), cK = expf(M - mn);
#pragma unroll
                for (int j = 0; j < 8; ++j) S[j] = cS * S[j] + cK * v[j];
                m = mn; }
#pragma unroll 1
            for (int kb = 0; kb < 64; kb += 8) { u32x4 raw[8];
#pragma unroll
                for (int kk = 0; kk < 8; ++kk) { const int c = dir ? (63 - kb - kk) : (kb + kk); raw[kk] = ld16(base + (size_t)c * 32768); }
#pragma unroll
                for (int kk = 0; kk < 8; ++kk) { const int c = dir ? (63 - kb - kk) : (kb + kk); unpack8(raw[kk], v); *(u32x4*)(base + (size_t)c * 32768) = pack8(S);
                    if (e == 0 && dc == 0) MPREV[(dir * 16 + bh) * 64 + c] = m;
                    const float M = scp[c * 2], be = scp[c * 2 + 1], mn = fmaxf(be + m, M), cS = __expf(be + m - mn), cK = __expf(M - mn);
#pragma unroll
                    for (int j = 0; j < 8; ++j) S[j] = cS * S[j] + cK * v[j];
                    m = mn; } }
        }
        for (int task = gt; task < 4096; task += NGT) {
            const int d = task & 127, bh = (task >> 7) & 15, dir = task >> 11;
            const float* nl = NLOC + (size_t)((dir * 16 + bh) * 66) * 128 + d; float* np = NPREV + (size_t)((dir * 16 + bh) * 64) * 128 + d;
            const float* scp = MSCAL + (size_t)((dir * 16 + bh) * 66) * 2;
            float S = 0.f, m = 0.f;
            for (int k = 0; k < 2; ++k) { const int cc = dir ? (65 - k) : (64 + k);
                const float M = scp[cc * 2], be = scp[cc * 2 + 1], mn = fmaxf(be + m, M); S = expf(be + m - mn) * S + expf(M - mn) * nl[cc * 128]; m = mn; }
            for (int k = 0; k < 64; ++k) { const int c = dir ? (63 - k) : k; np[c * 128] = S;
                const float M = scp[c * 2], be = scp[c * 2 + 1], mn = fmaxf(be + m, M); S = expf(be + m - mn) * S + expf(M - mn) * nl[c * 128]; m = mn; }
        }
    }
    }
    SEAM(4);

    for (int rep_ = 0; rep_ < NREP(5); ++rep_) { if (rep_) xcd_barrier(bar);
    if (IN(5)) {
        bf16_t* YRG = (bf16_t*)(ws + WS_YRG); bf16_t* YMG = (bf16_t*)(ws + WS_YMG);
        for (int u = bx; u < 1024 + 2048; u += G) {
            int tid = threadIdx.x; asm volatile("" : "+v"(tid)); const int lane = tid & 63;
            const int r = lane & 15, q = lane >> 4;
            if (u < 1024) {
                const int bh = u >> 6, c = u & 63, b = bh >> 2, h = bh & 3, t0 = c * 128;
                const bf16_t* Pb = P + (size_t)(b * SEQ) * LDP;
                LAS unsigned char* Qs = lds;
                LAS unsigned char* Ks = lds + 34816;
                LAS unsigned char* ATT = lds + 73984;
                LAS unsigned char* R3 = lds + 108800;
                LAS float* ARR = (LAS float*)(lds + 143616);
                LAS float *ERF = ARR, *ECF = ARR + 128, *INF = ARR + 256, *EMF = ARR + 384, *ERB = ARR + 512, *ECB = ARR + 640, *INB = ARR + 768, *EMB = ARR + 896, *CF = ARR + 1024, *CB = ARR + 1152;
                if (wave < 2) {
                    const int dir = wave;
                    const float bi = mgb[dir * 8 + h], bfv = mgb[dir * 8 + 4 + h], mprev = MPREV[(dir * 16 + bh) * 64 + c];
                    const bf16_t* gp = Pb + (size_t)t0 * LDP + C_MG + dir * 8 + h;
                    const float i_lo = bf2f(gp[(size_t)lane * LDP]) + bi, i_hi = bf2f(gp[(size_t)(lane + 64) * LDP]) + bi;
                    const float f_lo = logsigf_(bf2f(gp[(size_t)lane * LDP + 4]) + bfv), f_hi = logsigf_(bf2f(gp[(size_t)(lane + 64) * LDP + 4]) + bfv);
                    float c_lo = f_lo, c_hi = f_hi;
                    if (dir == 0) scan128_sum_prefix(c_lo, c_hi, lane); else scan128_sum_suffix(c_lo, c_hi, lane);
                    const float ec_lo = i_lo - c_lo, ec_hi = i_hi - c_hi;
                    float g_lo = ec_lo, g_hi = ec_hi;
                    if (dir == 0) scan128_max_prefix(g_lo, g_hi, lane); else scan128_max_suffix(g_lo, g_hi, lane);
                    const float mt_lo = c_lo + fmaxf(mprev, g_lo), mt_hi = c_hi + fmaxf(mprev, g_hi);
                    LAS float* ER = dir ? ERB : ERF; LAS float* EC = dir ? ECB : ECF; LAS float* INr = dir ? INB : INF; LAS float* EM = dir ? EMB : EMF;
                    ER[lane] = c_lo - mt_lo; ER[lane + 64] = c_hi - mt_hi; EC[lane] = ec_lo; EC[lane + 64] = ec_hi;
                    INr[lane] = __expf(c_lo + mprev - mt_lo); INr[lane + 64] = __expf(c_hi + mprev - mt_hi); EM[lane] = __expf(-mt_lo); EM[lane + 64] = __expf(-mt_hi);
                }
                {   const int ch = (tid >> 5) * 8, s0 = tid & 31; float w0[8], w1[8], w2[8], o[8]; u32x4 rows[4][3];
                    const float* wq = mconv + h * 128 + ch; ldw8(wq, w0); ldw8(wq + 1024, w1); ldw8(wq + 2048, w2);
                    conv_rows(Pb + C_MQ + h * 128 + ch, t0, s0, SEQ, rows);
#pragma unroll
                    for (int i = 0; i < 4; ++i) { conv8r(rows[i][0], rows[i][1], rows[i][2], w0, w1, w2, o); *(LAS u32x4*)(Qs + (s0 + 32 * i) * 272 + ch * 2) = pack8(o); }
                    const float* wk = mconv + 512 + h * 128 + ch; ldw8(wk, w0); ldw8(wk + 1024, w1); ldw8(wk + 2048, w2);
                    conv_rows(Pb + C_MK + h * 128 + ch, t0, s0, SEQ, rows);
#pragma unroll
                    for (int i = 0; i < 4; ++i) { conv8r(rows[i][0], rows[i][1], rows[i][2], w0, w1, w2, o);
#pragma unroll
                        for (int j = 0; j < 8; ++j) o[j] *= 0.08838834764831845f;
                        *(LAS u32x4*)(Ks + (s0 + 32 * i) * 272 + ch * 2) = pack8(o); } }
                if (tid < 256) { const int rowi = tid >> 4, dch = (tid & 15) * 8; float o[8];
#pragma unroll
                    for (int j = 0; j < 8; ++j) o[j] = (rowi < 2) ? NPREV[(size_t)((rowi * 16 + bh) * 64 + c) * 128 + dch + j] : 0.f;
                    *(LAS u32x4*)(Ks + (128 + rowi) * 272 + dch * 2) = pack8(o); }
                { u32x4 raw_[4];
#pragma unroll
                for (int i = 0; i < 4; ++i) { const int task = tid + NTHR * i, s = task & 127, e8 = (task >> 7) * 8; raw_[i] = ld16(Pb + (size_t)(t0 + s) * LDP + C_MV + h * 256 + e8); }
#pragma unroll
                for (int i = 0; i < 4; ++i) { const int task = tid + NTHR * i, s = task & 127, e8 = (task >> 7) * 8; const u32x4 v = raw_[i];
#pragma unroll
                    for (int j = 0; j < 4; ++j) { *(LAS bf16_t*)(R3 + ((e8 + 2 * j) * 136 + s) * 2) = (bf16_t)(v[j] & 0xffffu); *(LAS bf16_t*)(R3 + ((e8 + 2 * j + 1) * 136 + s) * 2) = (bf16_t)(v[j] >> 16); } } }
                __syncthreads();
                {   f32x4 qk[1][9];
#pragma unroll
                    for (int n = 0; n < 9; ++n) qk[0][n] = (f32x4){0.f, 0.f, 0.f, 0.f};
                    wave_mma<1, 9>(qk, Qs + (16 * wave) * 272, 272, Ks, 272, 128, lane);
#pragma unroll
                    for (int j = 0; j < 4; ++j) { const int p = 16 * wave + q * 4 + j;
                        const float erf_ = ERF[p], erb_ = ERB[p];
                        float af[8], ab[8], rsf = 0.f, rsb = 0.f;
#pragma unroll
                        for (int nb = 0; nb < 8; ++nb) { const int s = nb * 16 + r; const float xv = qk[0][nb][j];
                            af[nb] = (s <= p) ? xv * __expf(erf_ + ECF[s]) : 0.f; ab[nb] = (s >= p) ? xv * __expf(erb_ + ECB[s]) : 0.f; rsf += af[nb]; rsb += ab[nb]; }
                        rsf = row16_sum(rsf); rsb = row16_sum(rsb);
                        const float qnf = __shfl(qk[0][8][j], q * 16), qnb = __shfl(qk[0][8][j], q * 16 + 1);
                        const float inf_ = INF[p], inb_ = INB[p];
                        const float dnf = fmaxf(fabsf(rsf + inf_ * qnf), EMF[p]), dnb = fmaxf(fabsf(rsb + inb_ * qnb), EMB[p]);
                        const float rf = 1.f / dnf, rb = 1.f / dnb;
#pragma unroll
                        for (int nb = 0; nb < 8; ++nb) *(LAS bf16_t*)(ATT + (p * 136 + nb * 16 + r) * 2) = f2bf(af[nb] * rf + ab[nb] * rb);
                        if (r == 0) { CF[p] = inf_ * rf; CB[p] = inb_ * rb; }
                        __builtin_amdgcn_sched_barrier(0); }
                }
                __syncthreads();
                f32x4 y[2][1][8];
#pragma unroll
                for (int a = 0; a < 2; ++a)
#pragma unroll
                    for (int n = 0; n < 8; ++n) y[a][0][n] = (f32x4){0.f, 0.f, 0.f, 0.f};
                wave_mma<1, 8>(y[0], ATT + (16 * wave) * 272, 272, R3, 272, 128, lane);
                __syncthreads();
                { u32x4 raw_[4];
#pragma unroll
                for (int i = 0; i < 4; ++i) { const int task = tid + NTHR * i, s = task & 127, e8 = (task >> 7) * 8; raw_[i] = ld16(Pb + (size_t)(t0 + s) * LDP + C_MV + h * 256 + 128 + e8); }
#pragma unroll
                for (int i = 0; i < 4; ++i) { const int task = tid + NTHR * i, s = task & 127, e8 = (task >> 7) * 8; const u32x4 v = raw_[i];
#pragma unroll
                    for (int j = 0; j < 4; ++j) { *(LAS bf16_t*)(R3 + ((e8 + 2 * j) * 136 + s) * 2) = (bf16_t)(v[j] & 0xffffu); *(LAS bf16_t*)(R3 + ((e8 + 2 * j + 1) * 136 + s) * 2) = (bf16_t)(v[j] >> 16); } } }
                __syncthreads();
                wave_mma<1, 8>(y[1], ATT + (16 * wave) * 272, 272, R3, 272, 128, lane);
#pragma unroll 1
                for (int dir = 0; dir < 2; ++dir) {
                    __syncthreads();
                    {   LAS float* CX = dir ? CB : CF;
#pragma unroll 1
                        for (int i = 0; i < 4; ++i) { const int task = tid + NTHR * i, s = task >> 4, ch = (task & 15) * 8; float o[8];
                            unpack8(*(const LAS u32x4*)(Qs + s * 272 + ch * 2), o); const float cx = CX[s];
#pragma unroll
                            for (int j = 0; j < 8; ++j) o[j] *= cx;
                            *(LAS u32x4*)(Ks + s * 272 + ch * 2) = pack8(o); } }
#pragma unroll 1
                    for (int half = 0; half < 2; ++half) {
                        if (half) __syncthreads();
                        { u32x4 raw_[4];
#pragma unroll
                        for (int i = 0; i < 4; ++i) { const int task = tid + NTHR * i, e = task >> 4, dch = (task & 15) * 8; raw_[i] = ld16(MST + ((size_t)((dir * 16 + bh) * 66 + c) * 256 + half * 128 + e) * 128 + dch); }
#pragma unroll
                        for (int i = 0; i < 4; ++i) { const int task = tid + NTHR * i, e = task >> 4, dch = (task & 15) * 8; *(LAS u32x4*)(R3 + e * 272 + dch * 2) = raw_[i]; } }
                        __syncthreads();
                        if (half == 0) wave_mma<1, 8>(y[0], Ks + (16 * wave) * 272, 272, R3, 272, 128, lane);
                        else wave_mma<1, 8>(y[1], Ks + (16 * wave) * 272, 272, R3, 272, 128, lane);
                    }
                }
                __syncthreads();
#pragma unroll
                for (int j = 0; j < 4; ++j) { const int p = 16 * wave + q * 4 + j;
                    float s1 = 0.f;
#pragma unroll
                    for (int nb = 0; nb < 8; ++nb) s1 += y[0][0][nb][j] + y[1][0][nb][j];
                    const float mean = row16_sum(s1) * (1.f / 256.f);
                    float s2 = 0.f;
#pragma unroll
                    for (int nb = 0; nb < 8; ++nb) { const float a = y[0][0][nb][j] - mean, bb = y[1][0][nb][j] - mean; s2 += a * a + bb * bb; }
                    const float rstd = rsqrtf(row16_sum(s2) * (1.f / 256.f) + 1e-6f);
#pragma unroll
                    for (int half = 0; half < 2; ++half)
#pragma unroll
                        for (int nb = 0; nb < 8; ++nb) { const int e = half * 128 + nb * 16 + r;
                            *(LAS bf16_t*)(Qs + (p * 264 + e) * 2) = f2bf((y[half][0][nb][j] - mean) * rstd); } }
                __syncthreads();
                {   u32x4 gr_[8];
#pragma unroll
                    for (int i = 0; i < 8; ++i) { const int task = tid + NTHR * i, p = task >> 5, e8 = (task & 31) * 8; gr_[i] = ld16(P + (size_t)(b * SEQ + t0 + p) * LDP + C_MO + h * 256 + e8); }
#pragma unroll
                    for (int i = 0; i < 8; ++i) { const int task = tid + NTHR * i, p = task >> 5, e8 = (task & 31) * 8; float yv[8], gv[8];
                        unpack8(*(const LAS u32x4*)(Qs + (p * 264 + e8) * 2), yv); unpack8(gr_[i], gv);
#pragma unroll
                        for (int jj = 0; jj < 8; ++jj) yv[jj] *= sigmoidf_(gv[jj]);
                        *(u32x4*)(YMG + (size_t)(b * SEQ + t0 + p) * 1024 + h * 256 + e8) = pack8(yv); } }
                __syncthreads();
            } else {
                const int v = u - 1024; const int bh = v >> 6, c = v & 63, b = bh >> 3, h = bh & 7, t0 = c * 128;
                const bf16_t* Pb = P + (size_t)(b * SEQ) * LDP;
                LAS unsigned char* Qs = lds;
                LAS unsigned char* Ks = lds + 18432;
                LAS unsigned char* AP = lds;
                LAS unsigned char* ATT = lds + 36864;
                LAS unsigned char* VT = lds + 71680;
                LAS unsigned char* ST = lds + 106496;
                const float lgf = logsigf_(rdec[h]), lgb = logsigf_(rdec[8 + h]);
                {   const int s = tid >> 2, ic = (tid & 3) * 8; float a1[8], a2[8], k1[8], k2[8], o1[8], o2[8];
                    const bf16_t* qp = Pb + (size_t)(t0 + s) * LDP + C_RQ + h * 64 + ic; unpack8(ld16(qp), a1); unpack8(ld16(qp + 32), a2);
                    const bf16_t* kp = Pb + (size_t)(t0 + s) * LDP + C_RK + h * 64 + ic; unpack8(ld16(kp), k1); unpack8(ld16(kp + 32), k2);
                    float cs[8], sn[8]; ldw8(ROTC + (t0 + s) * 32 + ic, cs); ldw8(ROTS + (t0 + s) * 32 + ic, sn);
#pragma unroll
                    for (int j = 0; j < 8; ++j) { o1[j] = a1[j] * cs[j] - a2[j] * sn[j]; o2[j] = a2[j] * cs[j] + a1[j] * sn[j]; }
                    *(LAS u32x4*)(Qs + s * 144 + ic * 2) = pack8(o1); *(LAS u32x4*)(Qs + s * 144 + (32 + ic) * 2) = pack8(o2);
#pragma unroll
                    for (int j = 0; j < 8; ++j) { o1[j] = (k1[j] * cs[j] - k2[j] * sn[j]) * 0.125f; o2[j] = (k2[j] * cs[j] + k1[j] * sn[j]) * 0.125f; }
                    *(LAS u32x4*)(Ks + s * 144 + ic * 2) = pack8(o1); *(LAS u32x4*)(Ks + s * 144 + (32 + ic) * 2) = pack8(o2); }
                { u32x4 raw_[4];
#pragma unroll
                for (int i = 0; i < 4; ++i) { const int task = tid + NTHR * i, s = task & 127, e8 = (task >> 7) * 8; raw_[i] = ld16(Pb + (size_t)(t0 + s) * LDP + C_RV + h * 128 + e8); }
#pragma unroll
                for (int i = 0; i < 4; ++i) { const int task = tid + NTHR * i, s = task & 127, e8 = (task >> 7) * 8; const u32x4 vv = raw_[i];
#pragma unroll
                    for (int j = 0; j < 4; ++j) { *(LAS bf16_t*)(VT + ((e8 + 2 * j) * 136 + s) * 2) = (bf16_t)(vv[j] & 0xffffu); *(LAS bf16_t*)(VT + ((e8 + 2 * j + 1) * 136 + s) * 2) = (bf16_t)(vv[j] >> 16); } } }
                { u32x4 raw_[4];
#pragma unroll
                for (int i = 0; i < 4; ++i) { const int task = tid + NTHR * i, e = task >> 4, dd = task & 15, dir = dd >> 3, dch = (dd & 7) * 8; raw_[i] = ld16(RST + ((size_t)((dir * 32 + bh) * 66 + c) * 128 + e) * 64 + dch); }
#pragma unroll
                for (int i = 0; i < 4; ++i) { const int task = tid + NTHR * i, e = task >> 4, dd = task & 15, dir = dd >> 3, dch = (dd & 7) * 8; *(LAS u32x4*)(ST + e * 272 + (dir * 64 + dch) * 2) = raw_[i]; } }
                __syncthreads();
                {   f32x4 qk[1][8];
#pragma unroll
                    for (int n = 0; n < 8; ++n) qk[0][n] = (f32x4){0.f, 0.f, 0.f, 0.f};
                    wave_mma<1, 8>(qk, Qs + (16 * wave) * 144, 144, Ks, 144, 64, lane);
#pragma unroll
                    for (int j = 0; j < 4; ++j) { const int p = 16 * wave + q * 4 + j;
#pragma unroll
                        for (int nb = 0; nb < 8; ++nb) { const int s = nb * 16 + r, dl = p - s;
                            const float D = (dl > 0) ? __expf(lgf * (float)dl) : ((dl < 0) ? __expf(lgb * (float)(-dl)) : 2.f);
                            *(LAS bf16_t*)(ATT + (p * 136 + s) * 2) = f2bf(qk[0][nb][j] * D); } }
                }
                float qa[16];
                const int pa = tid >> 2, da = (tid & 3) * 16;
                {   float t8[8]; unpack8(*(const LAS u32x4*)(Qs + pa * 144 + da * 2), t8);
#pragma unroll
                    for (int j = 0; j < 8; ++j) qa[j] = t8[j];
                    unpack8(*(const LAS u32x4*)(Qs + pa * 144 + (da + 8) * 2), t8);
#pragma unroll
                    for (int j = 0; j < 8; ++j) qa[8 + j] = t8[j]; }
                __syncthreads();
                {   const float df = __expf(lgf * (float)(pa + 1)), db = __expf(lgb * (float)(128 - pa)); float o[8];
#pragma unroll
                    for (int hh = 0; hh < 2; ++hh) {
#pragma unroll
                        for (int j = 0; j < 8; ++j) o[j] = qa[hh * 8 + j] * df;
                        *(LAS u32x4*)(AP + pa * 272 + (da + hh * 8) * 2) = pack8(o);
#pragma unroll
                        for (int j = 0; j < 8; ++j) o[j] = qa[hh * 8 + j] * db;
                        *(LAS u32x4*)(AP + pa * 272 + (64 + da + hh * 8) * 2) = pack8(o); } }
                __syncthreads();
                f32x4 y[1][8];
#pragma unroll
                for (int n = 0; n < 8; ++n) y[0][n] = (f32x4){0.f, 0.f, 0.f, 0.f};
                wave_mma<1, 8>(y, ATT + (16 * wave) * 272, 272, VT, 272, 128, lane);
                wave_mma<1, 8>(y, AP + (16 * wave) * 272, 272, ST, 272, 128, lane);
#pragma unroll
                for (int j = 0; j < 4; ++j) { const int p = 16 * wave + q * 4 + j; const int t = b * SEQ + t0 + p;
                    float s1 = 0.f;
#pragma unroll
                    for (int nb = 0; nb < 8; ++nb) s1 += y[0][nb][j];
                    const float mean = row16_sum(s1) * (1.f / 128.f);
                    float s2 = 0.f;
#pragma unroll
                    for (int nb = 0; nb < 8; ++nb) { const float a = y[0][nb][j] - mean; s2 += a * a; }
                    const float rstd = rsqrtf(row16_sum(s2) * (1.f / 128.f) + 1e-6f);
#pragma unroll
                    for (int nb = 0; nb < 8; ++nb) { const int e = nb * 16 + r; *(LAS bf16_t*)(ATT + (p * 136 + e) * 2) = f2bf((y[0][nb][j] - mean) * rstd); } }
                __syncthreads();
                {   u32x4 gr_[4];
#pragma unroll
                    for (int i = 0; i < 4; ++i) { const int task = tid + NTHR * i, p = task >> 4, e8 = (task & 15) * 8; gr_[i] = ld16(P + (size_t)(b * SEQ + t0 + p) * LDP + C_RG + h * 128 + e8); }
#pragma unroll
                    for (int i = 0; i < 4; ++i) { const int task = tid + NTHR * i, p = task >> 4, e8 = (task & 15) * 8; float yv[8], gv[8];
                        unpack8(*(const LAS u32x4*)(ATT + (p * 136 + e8) * 2), yv); unpack8(gr_[i], gv);
#pragma unroll
                        for (int jj = 0; jj < 8; ++jj) yv[jj] *= gv[jj] * sigmoidf_(gv[jj]);
                        *(u32x4*)(YRG + (size_t)(b * SEQ + t0 + p) * 1024 + h * 128 + e8) = pack8(yv); } }
                __syncthreads();
            }
        }
    }
    }
    SEAM(5);

    for (int rep_ = 0; rep_ < NREP(6); ++rep_) { if (rep_) xcd_barrier(bar);
    if (IN(6)) {
        pg8::StaticOrder S; S.init(NTOK, DM, G, bx);
        { pg8::Gemm g{(const bf16_t*)(ws + WS_YRG), (const bf16_t*)(ws + WS_WRO), 1024, 1024}; pg8::EpiU<0> E{P, (bf16_t*)(ws + WS_U), C_GR}; pg8::gemm_phase<pg8::EpiU<0>, pg8::StaticOrder>(lds, g, S, E); }
        { pg8::Gemm g{(const bf16_t*)(ws + WS_YMG), (const bf16_t*)(ws + WS_WMO), 1024, 1024}; pg8::EpiU<1> E{P, (bf16_t*)(ws + WS_U), C_GM}; pg8::gemm_phase<pg8::EpiU<1>, pg8::StaticOrder>(lds, g, S, E); }
    }
    }
    SEAM(6);

    for (int rep_ = 0; rep_ < NREP(7); ++rep_) { if (rep_) xcd_barrier(bar);
    if (IN(7)) {
        pg8::StaticOrder S; S.init(NTOK, DM, G, bx);
        pg8::Gemm g{(const bf16_t*)(ws + WS_U), (const bf16_t*)(ws + WS_WO), DM, DM}; pg8::EpiX1 E{args.in[IN_X], MOD, args.out, (float*)(ws + WS_ROWSQ)};
        pg8::gemm_phase<pg8::EpiX1, pg8::StaticOrder>(lds, g, S, E);
    }
    }
    SEAM(7);

    for (int rep_ = 0; rep_ < NREP(8); ++rep_) { if (rep_) xcd_barrier(bar);
    if (IN(8)) {
        const float* g2 = args.in[IN_N2G]; const float* rowsq = (const float*)(ws + WS_ROWSQ); bf16_t* H2 = (bf16_t*)(ws + WS_H2); const float* x1 = args.out;
        for (int row = gw; row < NTOK; row += NGW) {
            const int b = row >> 13;
            float ss = (lane < 32) ? rowsq[(size_t)lane * NTOK + row] : 0.f;
            const float rstd = rsqrtf(wave_sum(ss) * (1.f / DM) + 1e-6f);
            const float* shp = MOD + b * 12288 + 3 * DM; const float* scp = shp + DM;
#pragma unroll
            for (int j = 0; j < 8; ++j) { const int idx = 4 * (lane + 64 * j); const f32x4 v = *(const f32x4*)(x1 + (size_t)row * DM + idx);
                const f32x4 g = *(const f32x4*)(g2 + idx), sh = *(const f32x4*)(shp + idx), sc = *(const f32x4*)(scp + idx);
                const f32x4 hv = v * rstd * g * (sc + 1.f) + sh; u32x2 o; o.x = pk2(hv[0], hv[1]); o.y = pk2(hv[2], hv[3]); *(u32x2*)(H2 + (size_t)row * DM + idx) = o; }
        }
        { u32x4* ix = (u32x4*)(ws + WS_IDX); const u32x4 inv = {0xFFF0FFF0u, 0xFFF0FFF0u, 0xFFF0FFF0u, 0xFFF0FFF0u};
          for (int i = gt; i < 64 * 16 * 512 * 16 * 2 / 16; i += NGT) ix[i] = inv; }
        const float* pd = args.in[IN_PD]; const float* pu = args.in[IN_PU]; bf16_t* d16 = (bf16_t*)(ws + WS_DN16); _Float16* u16 = (_Float16*)(ws + WS_UP16);
        for (int i = gt; i < 2 * (16384 * DM / 8); i += NGT) { const int which = i >= (16384 * DM / 8); const size_t k = (size_t)(which ? i - 16384 * DM / 8 : i) * 8;
            const float* s = (which ? pu : pd) + k; const f32x4 a = *(const f32x4*)s, b2 = *(const f32x4*)(s + 4);
            if (which) { half8_t o; o[0] = (_Float16)a[0]; o[1] = (_Float16)a[1]; o[2] = (_Float16)a[2]; o[3] = (_Float16)a[3]; o[4] = (_Float16)b2[0]; o[5] = (_Float16)b2[1]; o[6] = (_Float16)b2[2]; o[7] = (_Float16)b2[3]; *(half8_t*)(u16 + k) = o; }
            else { u32x4 o; o.x = pk2(a[0], a[1]); o.y = pk2(a[2], a[3]); o.z = pk2(b2[0], b2[1]); o.w = pk2(b2[2], b2[3]); *(u32x4*)(d16 + k) = o; } }
    }
    }
    SEAM(8);

    for (int rep_ = 0; rep_ < NREP(9); ++rep_) { if (rep_) xcd_barrier(bar);
    if (IN(9)) {
        pg8::StaticOrder S; S.init(NTOK, DM, G, bx);
        pg8::Gemm g{(const bf16_t*)(ws + WS_H2), (const bf16_t*)(ws + WS_WQ), DM, DM}; pg8::EpiQ E{(bf16_t*)(ws + WS_Q)};
        pg8::gemm_phase<pg8::EpiQ, pg8::StaticOrder>(lds, g, S, E);
    }
    }
    SEAM(9);

    for (int rep_ = 0; rep_ < NREP(10); ++rep_) { if (rep_) xcd_barrier(bar);
    if (IN(10)) {
        const bf16_t* Qb = (const bf16_t*)(ws + WS_Q); const bf16_t* K16 = (const bf16_t*)(ws + WS_KEYS); int* EID = (int*)(ws + WS_EID); float* GW = (float*)(ws + WS_GW);
        LAS unsigned char* QT = lds;
        LAS unsigned char* KY = lds + 67584;
        LAS unsigned* LST = (LAS unsigned*)(lds + 137216);
        int hprev = -1;
        u32x4 qn[8];
        if (bx < 2048) {
#pragma unroll
            for (int i = 0; i < 8; ++i) { const int task = tid + NTHR * i, tok = task >> 5, c8 = (task & 31) * 8; qn[i] = ld16(Qb + (size_t)((bx >> 3) * 128 + tok) * DM + (bx & 7) * 256 + c8); } }
        for (int u = bx; u < 2048; u += G) {
            const int tb = u >> 3, h = u & 7;
#pragma unroll
            for (int i = 0; i < 8; ++i) { const int task = tid + NTHR * i, tok = task >> 5, c8 = (task & 31) * 8; *(LAS u32x4*)(QT + tok * 528 + c8 * 2) = qn[i]; }
            if (h != hprev) { u32x4 raw_[8]; hprev = h;
#pragma unroll
            for (int i = 0; i < 8; ++i) { const int task = tid + NTHR * i, row = task >> 4, c8 = (task & 15) * 8; raw_[i] = ld16(K16 + ((size_t)h * 256 + row) * 128 + c8); }
#pragma unroll
            for (int i = 0; i < 8; ++i) { const int task = tid + NTHR * i, row = task >> 4, c8 = (task & 15) * 8; *(LAS u32x4*)(KY + row * 272 + c8 * 2) = raw_[i]; } }
            __syncthreads();
            if (u + G < 2048) { const int un = u + G;
#pragma unroll
                for (int i = 0; i < 8; ++i) { const int task = tid + NTHR * i, tok = task >> 5, c8 = (task & 31) * 8; qn[i] = ld16(Qb + (size_t)((un >> 3) * 128 + tok) * DM + (un & 7) * 256 + c8); } }
            const int r = lane & 15, q = lane >> 4;
            float L0[16], L1[16];
#pragma unroll
            for (int pp = 0; pp < 2; ++pp) {
                f32x4 sc[8][1];
#pragma unroll
                for (int mb = 0; mb < 8; ++mb) sc[mb][0] = (f32x4){0.f, 0.f, 0.f, 0.f};
                wave_mma<8, 1>(sc, KY + (pp * 128) * 272, 272, QT + (16 * wave) * 528 + pp * 256, 528, 128, lane);
                float L[16];
#pragma unroll
                for (int i = 0; i < 16; ++i) L[i] = -__builtin_inff();
#pragma unroll
                for (int mb = 0; mb < 8; ++mb)
#pragma unroll
                    for (int j = 0; j < 4; ++j) { const unsigned key = (unsigned)(mb * 16 + q * 4 + j);
                        ins16(L, __uint_as_float((__float_as_uint(sc[mb][0][j]) & ~127u) | key)); }
#pragma unroll
                for (int sh = 16; sh <= 32; sh <<= 1) { float o[16];
#pragma unroll
                    for (int i = 0; i < 16; ++i) o[i] = __shfl_xor(L[i], sh);
#pragma unroll
                    for (int i = 0; i < 16; ++i) ins16(L, o[i]); }
#pragma unroll
                for (int i = 0; i < 16; ++i) { if (pp == 0) L0[i] = L[i]; else L1[i] = L[i]; }
            }
            if (q == 0) {
#pragma unroll
                for (int i = 0; i < 16; ++i) { LST[(16 * wave + r) * 32 + i] = __float_as_uint(L0[i]); LST[(16 * wave + r) * 32 + 16 + i] = __float_as_uint(L1[i]); } }
            float T[16];
#pragma unroll
            for (int i = 0; i < 16; ++i) T[i] = -__builtin_inff();
#pragma unroll
            for (int a = 0; a < 16; ++a)
#pragma unroll
                for (int b2 = 0; b2 < 16; ++b2) if ((a + 1) * (b2 + 1) <= 16) { const float cnd = L0[a] + L1[b2]; ins16(T, __uint_as_float((__float_as_uint(cnd) & ~255u) | (unsigned)(a * 16 + b2))); }
            __syncthreads();
            float den = 0.f, ev[16];
#pragma unroll
            for (int i = 0; i < 16; ++i) { ev[i] = __expf(T[i] - T[0]); den += ev[i]; }
            const float rden = 1.f / den;
            const int tok = 16 * wave + r; const size_t ob = (size_t)(tb * 128 + tok) * 128 + h * 16 + q * 4;
#pragma unroll
            for (int kk = 0; kk < 4; ++kk) {
                const float tv = (q == 0) ? T[kk] : (q == 1 ? T[4 + kk] : (q == 2 ? T[8 + kk] : T[12 + kk]));
                const float gv = (q == 0) ? ev[kk] : (q == 1 ? ev[4 + kk] : (q == 2 ? ev[8 + kk] : ev[12 + kk]));
                const unsigned code = __float_as_uint(tv) & 255u;
                const unsigned i1 = LST[tok * 32 + (code >> 4)] & 127u, i2 = LST[tok * 32 + 16 + (code & 15u)] & 127u;
                EID[ob + kk] = (int)(i1 * 128u + i2); GW[ob + kk] = gv * rden; }
            __syncthreads();
        }
    }
    }
    SEAM(10);

    for (int rep_ = 0; rep_ < NREP(11); ++rep_) { if (rep_) xcd_barrier(bar);
    if (IN(11)) {
        const int* EID = (const int*)(ws + WS_EID); const float* GW = (const float*)(ws + WS_GW);
        unsigned short* IDX = (unsigned short*)(ws + WS_IDX); float* GJ = (float*)(ws + WS_GJ);
        int* OVC = (int*)(ws + WS_OVC); unsigned* OVE = (unsigned*)(ws + WS_OVE);
        for (int cku = gw; cku < NTOK / 8; cku += NGW) {
            const int hh = lane & 7, t = cku * 8 + (lane >> 3), TBi = t >> 9, tl = t & 511;
            int eid[16]; float gg[16];
#pragma unroll
            for (int q4 = 0; q4 < 4; ++q4) { const u32x4 e4 = *(const u32x4*)(EID + (size_t)t * 128 + hh * 16 + 4 * q4); const f32x4 g4v = *(const f32x4*)(GW + (size_t)t * 128 + hh * 16 + 4 * q4);
#pragma unroll
                for (int i = 0; i < 4; ++i) { eid[4 * q4 + i] = (int)e4[i]; gg[4 * q4 + i] = g4v[i]; } }
            unsigned hc[4] = {0u, 0u, 0u, 0u};
#pragma unroll
            for (int k = 0; k < 16; ++k) { const unsigned eb = EBLK(eid[k]), inc = 1u << ((eb & 3u) * 8u), sel = eb >> 2;
#pragma unroll
                for (int w4 = 0; w4 < 4; ++w4) hc[w4] += (sel == (unsigned)w4) ? inc : 0u; }
            unsigned run[4];
#pragma unroll
            for (int w4 = 0; w4 < 4; ++w4) { unsigned v = hc[w4];
#pragma unroll
                for (int o = 1; o < 8; o <<= 1) { const unsigned uu = (unsigned)__shfl_up((int)v, o, 8); if (hh >= o) v += uu; }
                run[w4] = v - hc[w4]; }
            int ovown = 0;
#pragma unroll
            for (int e = 0; e < 16; ++e) { const int bs = (int)((run[e >> 2] >> ((e & 3) * 8)) & 255u), ow = (int)((hc[e >> 2] >> ((e & 3) * 8)) & 255u);
                const int lo = bs > LCAP ? bs : LCAP; ovown += (bs + ow > lo) ? (bs + ow - lo) : 0; }
            int ovinc = ovown;
#pragma unroll
            for (int o = 1; o < 8; o <<= 1) { const int uu = __shfl_up(ovinc, o, 8); if (hh >= o) ovinc += uu; }
            int ovpos = ovinc - ovown;
            if (hh == 7) OVC[t] = ovinc;
            if (hh == 7) { unsigned char* CNT = (unsigned char*)(ws + WS_NMAXG);
#pragma unroll
                for (int e = 0; e < 16; ++e) { const unsigned tot = ((run[e >> 2] + hc[e >> 2]) >> ((e & 3) * 8)) & 255u; CNT[(size_t)(TBi * 16 + e) * 512 + tl] = (unsigned char)(tot < (unsigned)LCAP ? tot : (unsigned)LCAP); } }
#pragma unroll
            for (int k = 0; k < 16; ++k) { const unsigned eb = EBLK(eid[k]), sh = (eb & 3u) * 8u, sel = eb >> 2;
                const unsigned cur = (sel == 0u) ? run[0] : (sel == 1u ? run[1] : (sel == 2u ? run[2] : run[3]));
                const unsigned j = (cur >> sh) & 255u;
#pragma unroll
                for (int w4 = 0; w4 < 4; ++w4) run[w4] += (sel == (unsigned)w4) ? (1u << sh) : 0u;
                if (j < (unsigned)LCAP) { const unsigned el = EROWIN(eid[k]);
                    IDX[((size_t)(TBi * 16 + eb) * 512 + tl) * 16 + j] = (unsigned short)(((el << 2) | (el & 3u)) << 4); GJ[((size_t)(TBi * 16 + eb) * LCAP + j) * 512 + tl] = gg[k]; }
                else { OVE[((size_t)t * 128 + ovpos) * 2] = (unsigned)eid[k]; OVE[((size_t)t * 128 + ovpos) * 2 + 1] = __float_as_uint(gg[k]); ++ovpos; }
            }
        }
    }
    }
    SEAM(11);

    for (int rep_ = 0; rep_ < NREP(12); ++rep_) { if (rep_) xcd_barrier(bar);
    if (IN(12)) {
        const bf16_t* H2 = (const bf16_t*)(ws + WS_H2); const bf16_t* d16 = (const bf16_t*)(ws + WS_DN16);
        const unsigned short* IDX = (const unsigned short*)(ws + WS_IDX); const float* GJ = (const float*)(ws + WS_GJ); unsigned* EW = (unsigned*)(ws + WS_EW);
        LAS unsigned char* IDL = lds + 131072;
        for (int u = bx; u < 512; u += G) {
            int tid = threadIdx.x; asm volatile("" : "+v"(tid)); const int lane = tid & 63;
            const int xx = u & 7, rest = u >> 3, wq = rest & 31, eb = wq & 15, TBi = 4 * xx + 2 * (rest >> 5) + (wq >> 4);
            const int c4 = lane & 3, g4 = lane >> 2;
            LAS unsigned short* PERMS = (LAS unsigned short*)(lds + 155648); LAS unsigned* HIST = (LAS unsigned*)(lds + 157696); LAS unsigned char* CNTL = lds + 157760;
            __syncthreads();
            if (tid < 16) HIST[tid] = 0u;
            unsigned cnt2[2];
#pragma unroll
            for (int k2 = 0; k2 < 2; ++k2) { const int i = tid + NTHR * k2; const size_t hb = (size_t)((TBi * 2 + (i >> 9)) * 16 + eb) * 512 + (i & 511);
                const u32x4 e0 = *(const u32x4*)(IDX + hb * 16); const u32x2 e1 = *(const u32x2*)(IDX + hb * 16 + 8);
                *(LAS u32x2*)(IDL + i * 24) = (u32x2){e0[0], e0[1]}; *(LAS u32x2*)(IDL + i * 24 + 8) = (u32x2){e0[2], e0[3]}; *(LAS u32x2*)(IDL + i * 24 + 16) = e1;
                cnt2[k2] = ((const unsigned char*)(ws + WS_NMAXG))[hb]; CNTL[i] = (unsigned char)cnt2[k2]; }
            __syncthreads();
            unsigned rank2[2];
#pragma unroll
            for (int k2 = 0; k2 < 2; ++k2) rank2[k2] = __hip_atomic_fetch_add(&HIST[cnt2[k2]], 1u, __ATOMIC_RELAXED, __HIP_MEMORY_SCOPE_WORKGROUP);
            __syncthreads();
#pragma unroll
            for (int k2 = 0; k2 < 2; ++k2) { unsigned base = 0u; for (unsigned c2 = cnt2[k2] + 1u; c2 <= (unsigned)LCAP; ++c2) base += HIST[c2]; PERMS[base + rank2[k2]] = (unsigned short)(tid + NTHR * k2); }
            __syncthreads();
            int tlg[8], nmx[8];
#pragma unroll
            for (int grp = 0; grp < 8; ++grp) { tlg[grp] = PERMS[wave * 128 + grp * 16 + g4]; nmx[grp] = __builtin_amdgcn_readfirstlane((int)CNTL[PERMS[wave * 128 + grp * 16]]); }
            float acc[8][LCAP];
#pragma unroll
            for (int grp = 0; grp < 8; ++grp)
#pragma unroll
                for (int j = 0; j < LCAP; ++j) acc[grp][j] = 0.f;
            const bf16_t* dsrc = d16;
            const bf16_t* hsrc = H2 + (size_t)(TBi * 1024) * DM + c4 * 8;
#define DN_DMA1(fbv, bufv, i2) do { const int Lb = (i2) * 8192 + wave * 1024 + lane * 16, r = Lb >> 6, cp = (Lb >> 4) & 3; \
                __builtin_amdgcn_global_load_lds((const unsigned*)(dsrc + (size_t)EROW(eb, r) * DM + (fbv) * 32 + ((cp ^ (r & 3)) * 8)), (LAS unsigned*)(lds + (bufv) * 65536 + (i2) * 8192 + wave * 1024), 16, 0, 0); } while (0)
            u32x4 hq[8];
#pragma unroll
            for (int i2 = 0; i2 < 8; ++i2) DN_DMA1(0, 0, i2);
#pragma unroll
            for (int grp = 0; grp < 8; ++grp) hq[grp] = ld16(hsrc + (size_t)tlg[grp] * DM);
            asm volatile("s_waitcnt vmcnt(0)" ::: "memory");
            __syncthreads();
#pragma unroll 1
            for (int fb = 0; fb < 64; ++fb) {
                const bool more = (fb + 1 < 64);
                const unsigned boff = (unsigned)(fb & 1) << 16, c4s = (unsigned)c4 << 4;
#pragma unroll
                for (int grp = 0; grp < 8; ++grp) {
                    const LAS unsigned char* ip = IDL + tlg[grp] * 24;
                    const u32x2 ea = *(const LAS u32x2*)ip, ebb = *(const LAS u32x2*)(ip + 8), ec = *(const LAS u32x2*)(ip + 16);
                    if (grp >= 3) { if (more) { if (grp == 3) asm volatile("s_waitcnt vmcnt(13)" ::: "memory"); else asm volatile("s_waitcnt vmcnt(15)" ::: "memory"); }
                                    else { if (grp == 3) asm volatile("s_waitcnt vmcnt(4)" ::: "memory"); else if (grp == 4) asm volatile("s_waitcnt vmcnt(3)" ::: "memory"); else if (grp == 5) asm volatile("s_waitcnt vmcnt(2)" ::: "memory");
                                           else if (grp == 6) asm volatile("s_waitcnt vmcnt(1)" ::: "memory"); else asm volatile("s_waitcnt vmcnt(0)" ::: "memory"); } }
#pragma unroll
                    for (int jb = 0; jb < LCAP; jb += 4) {
                        const int bt = grp * 3 + (jb >> 2);
                        if (more && (bt % 3 == 0) && bt < 12) {
#pragma unroll
                            for (int i2 = 0; i2 < 2; ++i2) DN_DMA1(fb + 1, (fb + 1) & 1, (bt / 3) * 2 + i2); }
                        if (jb < nmx[grp]) {
                        u32x4 v[4];
#pragma unroll
                        for (int jj = 0; jj < 4; ++jj) { const int j = jb + jj; const unsigned wd = (j < 4) ? ea[j >> 1] : (j < 8 ? ebb[(j - 4) >> 1] : ec[(j - 8) >> 1]); const unsigned ko = (j & 1) ? (wd >> 16) : (wd & 0xFFFFu);
                            v[jj] = *(const LAS u32x4*)(lds + ((ko ^ c4s) + boff)); }
#pragma unroll
                        for (int jj = 0; jj < 4; ++jj) { float a = acc[grp][jb + jj];
#pragma unroll
                            for (int q4 = 0; q4 < 4; ++q4) { const unsigned xa = v[jj][q4], xb = hq[grp][q4]; a = __builtin_amdgcn_fdot2_f32_bf16(__builtin_bit_cast(bf16x2_t, xa), __builtin_bit_cast(bf16x2_t, xb), a, false); }
                            acc[grp][jb + jj] = a; }
                        }
                        __builtin_amdgcn_sched_barrier(0);
                    }
                    if (more) { const bf16_t* hp = hsrc + (size_t)tlg[grp] * DM + (fb + 1) * 32; asm volatile("global_load_dwordx4 %0, %1, off" : "=v"(hq[grp]) : "v"(hp) : "memory"); }
                }
                asm volatile("s_waitcnt vmcnt(5)" ::: "memory");
                __builtin_amdgcn_s_barrier();
            }
#undef DN_DMA1
#pragma unroll
            for (int grp = 0; grp < 8; ++grp) {
                const int tl = tlg[grp]; const size_t hb = (size_t)((TBi * 2 + (tl >> 9)) * 16 + eb);
#pragma unroll
                for (int j = 0; j < LCAP; ++j) {
                    float sacc = acc[grp][j]; sacc += __shfl_xor(sacc, 1); sacc += __shfl_xor(sacc, 2);
                    if (c4 == 0) { const unsigned ent = *(const LAS unsigned short*)(IDL + tl * 24 + j * 2); const size_t idx = (hb * LCAP + j) * 512 + (tl & 511); const bool valid = j < (int)CNTL[tl];
                        unsigned o = 0u;
                        if (valid) { const _Float16 wh = (_Float16)(GJ[idx] * gelu_erf(sacc)); o = (ent & 0xFFC0u) | ((unsigned)__builtin_bit_cast(unsigned short, wh) << 16); }
                        EW[((size_t)(TBi * 16 + eb) * 1024 + tl) * LCAP + j] = o; }
                }
            }
        }
    }
    }
    SEAM(12);

    for (int rep_ = 0; rep_ < NREP(13); ++rep_) { if (rep_) xcd_barrier(bar);
    if (IN(13)) {
        const _Float16* u16 = (const _Float16*)(ws + WS_UP16); const unsigned* EW = (const unsigned*)(ws + WS_EW);
        float* out = args.out;
        {
            const bf16_t* H2o = (const bf16_t*)(ws + WS_H2); const bf16_t* d16o = (const bf16_t*)(ws + WS_DN16);
            const int* OVC = (const int*)(ws + WS_OVC); unsigned* OVE = (unsigned*)(ws + WS_OVE);
            int novN = (gw < NTOK) ? OVC[gw] : 0; u32x4 oN = (gw < NTOK) ? *(const u32x4*)(OVE + (size_t)gw * 256) : (u32x4){0u, 0u, 0u, 0u};
            for (int t = gw; t < NTOK; t += NGW) {
                const int nov = __builtin_amdgcn_readfirstlane(novN); const u32x4 o01 = oN;
                if (t + NGW < NTOK) { novN = OVC[t + NGW]; oN = *(const u32x4*)(OVE + (size_t)(t + NGW) * 256); }
                if (nov > 0) {
                    u32x4 hx[4];
#pragma unroll
                    for (int j = 0; j < 4; ++j) hx[j] = ld16(H2o + (size_t)t * DM + 8 * (lane + 64 * j));
                    for (int k0 = 0; k0 < nov; k0 += 2) {
                        u32x4 dr[2][4]; float gk[2];
#pragma unroll
                        for (int kk = 0; kk < 2; ++kk) { const bool ok = (k0 + kk < nov); const int k = ok ? k0 + kk : k0;
                            const unsigned eu = (k0 == 0) ? ((kk == 1 && ok) ? o01.z : o01.x) : OVE[((size_t)t * 128 + k) * 2], gu = (k0 == 0) ? ((kk == 1 && ok) ? o01.w : o01.y) : OVE[((size_t)t * 128 + k) * 2 + 1];
                            const int e = __builtin_amdgcn_readfirstlane((int)eu); gk[kk] = __uint_as_float(gu);
#pragma unroll
                            for (int j = 0; j < 4; ++j) dr[kk][j] = ld16(d16o + (size_t)e * DM + 8 * (lane + 64 * j)); }
#pragma unroll
                        for (int kk = 0; kk < 2; ++kk) { float sdot = 0.f;
#pragma unroll
                            for (int j = 0; j < 4; ++j)
#pragma unroll
                                for (int q4 = 0; q4 < 4; ++q4) { const unsigned xa = dr[kk][j][q4], xb = hx[j][q4]; sdot = __builtin_amdgcn_fdot2_f32_bf16(__builtin_bit_cast(bf16x2_t, xa), __builtin_bit_cast(bf16x2_t, xb), sdot, false); }
                            sdot = wave_sum(sdot);
                            if (k0 + kk < nov && lane == 0) OVE[((size_t)t * 128 + k0 + kk) * 2 + 1] = pk2(0.f, gk[kk] * gelu_erf(sdot)) & 0xffff0000u; }
                    }
                }
            }
        }
        for (int u = bx; u < 2048; u += G) {
            int tid = threadIdx.x; asm volatile("" : "+v"(tid)); const int lane = tid & 63;
            const int xx = u & 7, rest = u >> 3, TBi = rest & 31, fb = xx + 8 * (rest >> 5);
            const int c4 = lane & 3, g4 = lane >> 2;
            float acc[8][8];
#pragma unroll
            for (int grp = 0; grp < 8; ++grp)
#pragma unroll
                for (int i = 0; i < 8; ++i) acc[grp][i] = 0.f;
            const _Float16* usrc = u16 + fb * 32;
            const unsigned* esrc = EW + ((size_t)(TBi * 16) * 1024 + wave * 128 + g4) * LCAP;
            const unsigned evo = (unsigned)(wave * 128 + g4) * (LCAP * 4u);
#define UP_DMA1(ebv, bufv, i2) do { const int Lb = (i2) * 8192 + wave * 1024 + lane * 16, r = Lb >> 6, cp = (Lb >> 4) & 3; \
                __builtin_amdgcn_global_load_lds((const unsigned*)(usrc + (size_t)EROW(ebv, r) * DM + (cp * 8)), (LAS unsigned*)(lds + (bufv) * 65536 + (i2) * 8192 + wave * 1024), 16, 0, 0); } while (0)
#define UP_DMA(ebv, bufv) do { _Pragma("unroll") for (int i2 = 0; i2 < 8; ++i2) { const int Lb = i2 * 8192 + wave * 1024 + lane * 16, r = Lb >> 6, cp = (Lb >> 4) & 3; \
                __builtin_amdgcn_global_load_lds((const unsigned*)(usrc + (size_t)EROW(ebv, r) * DM + (cp * 8)), (LAS unsigned*)(lds + (bufv) * 65536 + i2 * 8192 + wave * 1024), 16, 0, 0); } } while (0)
            u32x4 ew[8][3];
            __syncthreads();
            if (!VARON(13, VAR_NODMA)) UP_DMA(0, 0);
#pragma unroll
            for (int grp = 0; grp < 8; ++grp)
#pragma unroll
                for (int j = 0; j < 3; ++j) ew[grp][j] = *(const u32x4*)(esrc + (size_t)grp * 16 * LCAP + 4 * j);
            asm volatile("s_waitcnt vmcnt(0)" ::: "memory");
            __syncthreads();
#pragma unroll 1
            for (int eb = 0; eb < 16; ++eb) {
                const bool more = (eb + 1 < 16);
                const unsigned kb = (unsigned)(size_t)lds + ((unsigned)(eb & 1) << 16) + ((unsigned)c4 << 4);
#define UP_ADDR(e_) ({ unsigned a_; asm("v_add_u32_sdwa %0, %1, %2 dst_sel:DWORD dst_unused:UNUSED_PAD src0_sel:WORD_0 src1_sel:DWORD" : "=v"(a_) : "v"(e_), "v"(kb)); a_; })
                u32x4 vc[4], vn[4];
#pragma unroll
                for (int jj = 0; jj < 4; ++jj) vc[jj] = *(const LAS u32x4*)(size_t)UP_ADDR(ew[0][0][jj]);
                unsigned a16[4];
#pragma unroll
                for (int bt = 0; bt < 24; ++bt) {
                    const int grp = bt / 3, jb = (bt % 3) * 4;
                    if (jb == 0) {
#pragma unroll
                        for (int q4 = 0; q4 < 4; ++q4) a16[q4] = 0u; }
                    if (more && (bt % 4 == 0) && bt < 16) {
#pragma unroll
                        for (int i2 = 0; i2 < 2; ++i2) UP_DMA1(eb + 1, (eb + 1) & 1, (bt / 4) * 2 + i2); }
                    if (bt == 16) {
                        if (more) asm volatile("s_waitcnt vmcnt(23)" ::: "memory");
                        else asm volatile("s_waitcnt vmcnt(0)" ::: "memory"); }
                    if (bt + 1 < 24) { const int g2 = (bt + 1) / 3, j2 = ((bt + 1) % 3) * 4;
#pragma unroll
                        for (int jj = 0; jj < 4; ++jj) vn[jj] = *(const LAS u32x4*)(size_t)UP_ADDR(ew[g2][j2 >> 2][jj]); }
#pragma unroll
                    for (int jj = 0; jj < 4; ++jj) {
#pragma unroll
                        for (int q4 = 0; q4 < 4; ++q4) { const unsigned xv = vc[jj][q4]; asm("v_pk_fma_f16 %0, %1, %2, %0 op_sel:[0,1,0] op_sel_hi:[1,1,1]" : "+v"(a16[q4]) : "v"(xv), "v"(ew[grp][jb >> 2][jj])); } }
                    if (jb == 8) {
#pragma unroll
                        for (int q4 = 0; q4 < 4; ++q4) { const unsigned ab = a16[q4]; acc[grp][2 * q4] = fmix_lo(1.0f, ab, acc[grp][2 * q4]); acc[grp][2 * q4 + 1] = fmix_hi(1.0f, ab, acc[grp][2 * q4 + 1]); }
                        if (more) {
#pragma unroll
                            for (int j = 0; j < 3; ++j) { const unsigned* ep = EW + (size_t)(TBi * 16 + eb + 1) * 1024 * LCAP + (grp >> 2) * (64 * LCAP);
                                asm volatile("global_load_dwordx4 %0, %1, %2 offset:%3" : "=v"(ew[grp][j]) : "v"(evo), "s"(ep), "n"((grp & 3) * 16 * LCAP * 4 + j * 16) : "memory"); } } }
#pragma unroll
                    for (int jj = 0; jj < 4; ++jj) vc[jj] = vn[jj];
                }
                asm volatile("s_waitcnt vmcnt(6)" ::: "memory");
                __builtin_amdgcn_s_barrier();
            }
#undef UP_DMA
#undef UP_DMA1
#undef UP_ADDR
#pragma unroll
            for (int grp = 0; grp < 8; ++grp) { const int t = TBi * 1024 + wave * 128 + grp * 16 + g4, col = fb * 32 + c4 * 8; const int b = t >> 13;
                float* xp = out + (size_t)t * DM + col; const float* gp = MOD + b * 12288 + 5 * DM + col;
                float* xd = (rep_ == NREP(13) - 1) ? xp : (float*)(ws + Z3) + (size_t)t * DM + col;
#pragma unroll
                for (int hh = 0; hh < 2; ++hh) { f32x4 xv = *(const f32x4*)(xp + 4 * hh); const f32x4 gv = *(const f32x4*)(gp + 4 * hh);
#pragma unroll
                    for (int i = 0; i < 4; ++i) xv[i] += gv[i] * acc[grp][4 * hh + i];
                    *(f32x4*)(xd + 4 * hh) = xv; } }
        }
    }
    }
    SEAM(13);

    if (IN(14)) {
        const _Float16* u16 = (const _Float16*)(ws + WS_UP16);
        const int* OVC = (const int*)(ws + WS_OVC); const unsigned* OVE = (const unsigned*)(ws + WS_OVE); const float* fg = args.in[IN_FG]; float* out = args.out;
        int novN = (gw < NTOK) ? OVC[gw] : 0; u32x4 oN = (gw < NTOK) ? *(const u32x4*)(OVE + (size_t)gw * 256) : (u32x4){0u, 0u, 0u, 0u};
        for (int t = gw; t < NTOK; t += NGW) {
            const int b = t >> 13;
            const int nov = __builtin_amdgcn_readfirstlane(novN); const u32x4 o01 = oN;
            if (t + NGW < NTOK) { novN = OVC[t + NGW]; oN = *(const u32x4*)(OVE + (size_t)(t + NGW) * 256); }
            float xr[32];
#pragma unroll
            for (int j = 0; j < 4; ++j) { const int idx = 8 * (lane + 64 * j); const f32x4 a = *(const f32x4*)(out + (size_t)t * DM + idx), bq = *(const f32x4*)(out + (size_t)t * DM + idx + 4);
#pragma unroll
                for (int i = 0; i < 4; ++i) { xr[8 * j + i] = a[i]; xr[8 * j + 4 + i] = bq[i]; } }
            if (nov > 0) {
                const float* gt2 = MOD + b * 12288 + 5 * DM;
                for (int k0 = 0; k0 < nov; k0 += 2) {
                    half8_t ur[2][4]; float wv[2];
#pragma unroll
                    for (int kk = 0; kk < 2; ++kk) { const bool ok = (k0 + kk < nov); const int k = ok ? k0 + kk : k0;
                        const unsigned eu = (k0 == 0) ? ((kk == 1 && ok) ? o01.z : o01.x) : OVE[((size_t)t * 128 + k) * 2], wu = (k0 == 0) ? ((kk == 1) ? o01.w : o01.y) : OVE[((size_t)t * 128 + k) * 2 + 1];
                        const int e = __builtin_amdgcn_readfirstlane((int)eu); wv[kk] = ok ? __uint_as_float(wu) : 0.f;
#pragma unroll
                        for (int j = 0; j < 4; ++j) ur[kk][j] = *(const half8_t*)(u16 + (size_t)e * DM + 8 * (lane + 64 * j)); }
#pragma unroll
                    for (int kk = 0; kk < 2; ++kk)
#pragma unroll
                        for (int j = 0; j < 4; ++j) { const int idx = 8 * (lane + 64 * j); const f32x4 ga = *(const f32x4*)(gt2 + idx), gb = *(const f32x4*)(gt2 + idx + 4);
#pragma unroll
                            for (int i = 0; i < 4; ++i) { xr[8 * j + i] += ga[i] * wv[kk] * (float)ur[kk][j][i]; xr[8 * j + 4 + i] += gb[i] * wv[kk] * (float)ur[kk][j][4 + i]; } }
                }
            }
            float ss = 0.f;
#pragma unroll
            for (int i = 0; i < 32; ++i) ss += xr[i] * xr[i];
            const float rstd = rsqrtf(wave_sum(ss) * (1.f / DM) + 1e-6f);
#pragma unroll
            for (int j = 0; j < 4; ++j) { const int idx = 8 * (lane + 64 * j);
#pragma unroll
                for (int hh = 0; hh < 2; ++hh) { const f32x4 gq = *(const f32x4*)(fg + idx + 4 * hh); f32x4 o;
#pragma unroll
                    for (int i = 0; i < 4; ++i) o[i] = xr[8 * j + 4 * hh + i] * rstd * gq[i];
                    *(f32x4*)(out + (size_t)t * DM + idx + 4 * hh) = o; } }
        }
    }
#undef IN
#undef SEAM
}

extern "C" void kernel_launch(void* const* d_in, const int* in_sizes, int n_in, void* d_out, int out_size, void* d_ws, size_t ws_size, hipStream_t stream) {
    static int grid = 0;
    if (grid == 0) {
        if (n_in != 20 || out_size != NTOK * DM || ws_size < WS_END) { fprintf(stderr, "kernel_launch: unexpected problem (n_in %d, out %d, ws %zu)\n", n_in, out_size, ws_size); grid = -1; return; }
        int dev = 0, cus = 0, per_cu = 0;
        if (hipGetDevice(&dev) != hipSuccess || hipDeviceGetAttribute(&cus, hipDeviceAttributeMultiprocessorCount, dev) != hipSuccess) { grid = -1; return; }
        if (hipFuncSetAttribute((const void*)fwd_kernel, hipFuncAttributeMaxDynamicSharedMemorySize, LDS_BYTES) != hipSuccess) { fprintf(stderr, "kernel_launch: hipFuncSetAttribute failed\n"); grid = -1; return; }
        if (hipOccupancyMaxActiveBlocksPerMultiprocessor(&per_cu, (const void*)fwd_kernel, NTHR, LDS_BYTES) != hipSuccess || per_cu < 1) { fprintf(stderr, "kernel_launch: occupancy query says %d blocks per CU\n", per_cu); grid = -1; (void)hipGetLastError(); return; }
        grid = cus;
    }
    if (grid < 0) return;
    (void)hipMemsetAsync((char*)d_ws + WS_CTL, 0, 64 * 1024, stream);
    Args a{};
    for (int i = 0; i < 20; ++i) a.in[i] = (const float*)d_in[i];
    a.out = (float*)d_out; a.ws = (unsigned char*)d_ws;
#if MK_N_LAUNCHES == 1
    a.ph_lo = 0; a.ph_hi = NPHASES;
    void* kargs[] = {&a};
    hipError_t e = hipLaunchCooperativeKernel((const void*)fwd_kernel, dim3(grid), dim3(NTHR), kargs, LDS_BYTES, stream);
    if (e != hipSuccess) fprintf(stderr, "kernel_launch: cooperative launch failed: %s (grid %d)\n", hipGetErrorString(e), grid);
#else
    for (int p = 0; p < NPHASES; ++p) { a.ph_lo = p; a.ph_hi = p + 1; hipLaunchKernelGGL(fwd_kernel, dim3(grid), dim3(NTHR), LDS_BYTES, stream, a); }
#endif
}
```

```cpp
#include <hip/hip_runtime.h>
#include <hip/hip_cooperative_groups.h>
#include <cstdio>
#include <cstdint>
namespace cg = cooperative_groups;

#ifndef MK_N_LAUNCHES
#define MK_N_LAUNCHES 1
#endif
#define NPHASES 15

#define LAS __attribute__((address_space(3)))
typedef unsigned short bf16_t;
typedef short bf16x8 __attribute__((ext_vector_type(8)));
typedef float f32x4 __attribute__((ext_vector_type(4)));
typedef unsigned u32x4 __attribute__((ext_vector_type(4)));
typedef unsigned u32x2 __attribute__((ext_vector_type(2)));
typedef __bf16 bf16x2_t __attribute__((ext_vector_type(2)));
typedef _Float16 half8_t __attribute__((ext_vector_type(8)));
typedef _Float16 h2v_t __attribute__((ext_vector_type(2)));

constexpr int DM = 2048, NBATCH = 4, SEQ = 8192, CTXL = 256;
constexpr int NTOK = NBATCH * SEQ;
constexpr int NCTXT = NBATCH * CTXL;
constexpr int MROWS = NTOK + NCTXT;
constexpr int LDP = 10256, NPADW = 10496;
constexpr int C_RQ = 0, C_RK = 512, C_RV = 1024, C_RG = 2048, C_MQ = 3072, C_MK = 3584, C_MV = 4096, C_MO = 5120, C_GR = 6144, C_GM = 8192, C_MG = 10240;
constexpr int NWAVES = 8, NTHR = 512;
constexpr int LDS_BYTES = 160 * 1024;
constexpr int LDS_MISC = 160 * 1024 - 64;
constexpr int LCAP = 12;

constexpr size_t KiB = 1024, MiB = 1024 * 1024;
constexpr size_t WS_CTL = 0;
constexpr size_t WS_MOD = 64 * KiB;
constexpr size_t WS_ROTC = 512 * KiB;
constexpr size_t WS_ROTS = 512 * KiB + 1 * MiB;
constexpr size_t WS_ROWSQ = 2 * MiB + 512 * KiB;
constexpr size_t WS_MSCAL = 6 * MiB + 512 * KiB;
constexpr size_t WS_MPREV = WS_MSCAL + 64 * KiB;
constexpr size_t WS_NLOC = 7 * MiB;
constexpr size_t WS_NPREV = 8 * MiB + 256 * KiB;
constexpr size_t WS_WRO = 10 * MiB;
constexpr size_t WS_WMO = 14 * MiB;
constexpr size_t WS_WO = 18 * MiB;
constexpr size_t WS_WQ = 26 * MiB;
constexpr size_t WS_KEYS = 34 * MiB;
constexpr size_t Z2 = 35 * MiB;
constexpr size_t WS_P = Z2;
constexpr size_t Z3 = 676 * MiB;
constexpr size_t WS_H1 = Z3;
constexpr size_t WS_WINT = Z3 + 132 * MiB;
constexpr size_t WS_PCTX = Z3 + 326 * MiB;
constexpr size_t WS_RST = Z3;
constexpr size_t WS_MST = Z3 + 66 * MiB;
constexpr size_t WS_YRG = Z3 + 198 * MiB;
constexpr size_t WS_YMG = Z3 + 262 * MiB;
constexpr size_t WS_U = Z3;
constexpr size_t WS_H2 = Z2;
constexpr size_t WS_DN16 = Z2 + 128 * MiB;
constexpr size_t WS_UP16 = Z2 + 192 * MiB;
constexpr size_t WS_Q = Z2 + 256 * MiB;
constexpr size_t WS_EID = Z2 + 384 * MiB;
constexpr size_t WS_GW = Z2 + 400 * MiB;
constexpr size_t WS_IDX = Z2 + 416 * MiB;
constexpr size_t WS_GJ = Z2 + 432 * MiB;
constexpr size_t WS_EW = Z2 + 464 * MiB;
constexpr size_t WS_NMAXG = Z2 + 496 * MiB;
constexpr size_t WS_OVC = Z2 + 497 * MiB;
constexpr size_t WS_OVE = Z2 + 498 * MiB;
constexpr size_t WS_END = 1024 * MiB;

__device__ __forceinline__ float bf2f(unsigned short h) { return __uint_as_float(((unsigned)h) << 16); }
__device__ __forceinline__ unsigned pk2(float lo, float hi) { unsigned r; asm("v_cvt_pk_bf16_f32 %0, %1, %2" : "=v"(r) : "v"(lo), "v"(hi)); return r; }
__device__ __forceinline__ unsigned short f2bf(float f) { return (unsigned short)(pk2(f, 0.f) & 0xffffu); }
__device__ __forceinline__ void unpack8(const u32x4 v, float* f) {
#pragma unroll
    for (int i = 0; i < 4; ++i) { f[2 * i] = __uint_as_float(v[i] << 16); f[2 * i + 1] = __uint_as_float(v[i] & 0xffff0000u); }
}
__device__ __forceinline__ u32x4 pack8(const float* f) { u32x4 o; o.x = pk2(f[0], f[1]); o.y = pk2(f[2], f[3]); o.z = pk2(f[4], f[5]); o.w = pk2(f[6], f[7]); return o; }
__device__ __forceinline__ float sigmoidf_(float x) { return 1.f / (1.f + __expf(-x)); }
__device__ __forceinline__ float logsigf_(float x) { return fminf(x, 0.f) - log1pf(expf(-fabsf(x))); }
__device__ __forceinline__ float wave_sum(float v) {
#pragma unroll
    for (int o = 1; o < 64; o <<= 1) v += __shfl_xor(v, o);
    return v;
}
__device__ __forceinline__ float wave_max(float v) {
#pragma unroll
    for (int o = 1; o < 64; o <<= 1) v = fmaxf(v, __shfl_xor(v, o));
    return v;
}
__device__ __forceinline__ float row16_sum(float v) {
    v += __shfl_xor(v, 1); v += __shfl_xor(v, 2); v += __shfl_xor(v, 4); v += __shfl_xor(v, 8); return v;
}
#define LDS_WAIT() asm volatile("s_waitcnt lgkmcnt(0)" ::: "memory")

namespace pg8 {
constexpr int BM = 256, BK = 64, HALF = 128, HTB = HALF * BK * 2, STAGE_BYTES = 8 * HTB, NXCD = 8, WGM = 8;
__host__ __device__ __forceinline__ int lds_byte(int r, int c) { const int st = (r >> 4) * 2 + (c >> 5), rr = r & 15, cc = c & 31, ob = rr * 64 + cc * 2; return st * 1024 + (ob ^ (((ob >> 9) & 1) << 5)); }
__host__ __device__ __forceinline__ void stage_rc(int b, int& R, int& C) { const int st = b / 1024, sb = b % 1024, swz = sb ^ (((sb >> 9) & 1) << 5); R = (st >> 1) * 16 + swz / 64; C = (st & 1) * 32 + (swz % 64) / 2; }
__host__ __device__ __forceinline__ int perm32(int rho) { const int n = rho >> 4, i = rho & 15; return 8 * (i >> 2) + 4 * n + (i & 3); }
struct Unit { int pm, pn; };
struct Gemm { const bf16_t* A; const bf16_t* Bt; int lda; int K; };

__device__ __forceinline__ void static_map(int L, int nM, int nN, Unit& u) {
    const int nwg = nM * nN; int wgid = L;
    { const int q = nwg / NXCD, r = nwg % NXCD, xcd = wgid % NXCD, off = wgid / NXCD; wgid = (xcd < r ? xcd * (q + 1) : r * (q + 1) + (xcd - r) * q) + off; }
    const int nig = WGM * nN, gid = wgid / nig, fm = gid * WGM, gsz = (nM - fm) < WGM ? (nM - fm) : WGM;
    u.pm = fm + ((wgid % nig) % gsz); u.pn = (wgid % nig) / gsz;
}
struct StaticOrder {
    int nM, nN, nwg, G, c;
    __device__ __forceinline__ void init(int M, int N, int G_, int c_) { nM = M / BM; nN = N / BM; nwg = nM * nN; G = G_; c = c_; }
    __device__ __forceinline__ bool next(int i, Unit& u) const { const long L = (long)i * G + c; if (L >= nwg) return false; static_map((int)L, nM, nN, u); return true; }
};
struct OrderG1 {
    int G, c;
    __device__ __forceinline__ bool next(int i, Unit& u) const {
        const long L = (long)i * G + c;
        if (L < 128 * 41) { static_map((int)L, 128, 41, u); return true; }
        const int j = (int)(L - 128 * 41); if (j >= 52) return false;
        const int t = j >> 2; u.pm = 128 + (j & 3); u.pn = (t < 6) ? (2 + t) : (t < 12 ? 14 + (t - 6) : 40); return true;
    }
};

template <class Epi, class Sched, bool ALIGN_EPI = true, bool SP2 = true>
__device__ __forceinline__ void gemm_phase(LAS unsigned char* lds, const Gemm g, const Sched& S, const Epi& E) {
    const int tid = threadIdx.x, wid = __builtin_amdgcn_readfirstlane(tid >> 6), lane = tid & 63, wr = wid >> 2, wc = wid & 3, fr = lane & 15, fq = lane >> 4;
    const int K = g.K, nt = K / BK, lda = g.lda;
    unsigned voffA[2], voffB[2];
#pragma unroll
    for (int i = 0; i < 2; ++i) { int R, C; stage_rc(tid * 16 + i * 8192, R, C); const int Rb = Epi::PERM ? ((R & ~31) + perm32(R & 31)) : R;
        voffA[i] = (unsigned)(R * lda + C) * 2u; voffB[i] = (unsigned)(Rb * K + C) * 2u; }
    const size_t kstep = (size_t)(BK * 2);
    const size_t hstepA = (size_t)HALF * lda * 2, hstepB = (size_t)HALF * K * 2;
    const size_t tstepA = 2 * hstepA, tstepB = 2 * hstepB;
    const unsigned ldsw = (unsigned)wid * 1024u;
    const int aoff = lds_byte(wr * 64 + fr, fq * 8), boff = lds_byte(wc * 32 + fr, fq * 8);
#define PG8_SA(b, h) (((b) * 2 + (h)) * HTB)
#define PG8_SB(b, h) ((4 + (b) * 2 + (h)) * HTB)
#define PG8_STAGE(bufoff, gbase, voff) do { _Pragma("unroll") for (int _i = 0; _i < 2; ++_i) \
        __builtin_amdgcn_global_load_lds((const unsigned*)((const char*)(gbase) + (voff)[_i]), (LAS unsigned*)(lds + (bufoff) + ldsw + _i * 8192), 16, 0, 0); } while (0)
#define PG8_LDA(dst, b, h) do { _Pragma("unroll") for (int m = 0; m < 4; ++m) _Pragma("unroll") for (int k = 0; k < 2; ++k) dst[m][k] = *(const LAS bf16x8*)(lds + PG8_SA(b, h) + aoff + m * 2048 + k * 1024); } while (0)
#define PG8_LDB(dst, b, h) do { _Pragma("unroll") for (int n = 0; n < 2; ++n) _Pragma("unroll") for (int k = 0; k < 2; ++k) dst[n][k] = *(const LAS bf16x8*)(lds + PG8_SB(b, h) + boff + n * 2048 + k * 1024); } while (0)
#define PG8_MMA(ai, bj, At, Bt) do { __builtin_amdgcn_s_setprio(1); _Pragma("unroll") for (int m = 0; m < 4; ++m) _Pragma("unroll") for (int n = 0; n < 2; ++n) _Pragma("unroll") for (int k = 0; k < 2; ++k) \
        acc[ai][bj][m][n] = __builtin_amdgcn_mfma_f32_16x16x32_bf16(Bt[n][k], At[m][k], acc[ai][bj][m][n], 0, 0, 0); __builtin_amdgcn_s_setprio(0); } while (0)
#define PG8_WAIT_V(n) asm volatile("s_waitcnt vmcnt(" #n ")" ::: "memory")
#define PG8_WAIT_L(n) asm volatile("s_waitcnt lgkmcnt(" #n ")" ::: "memory")
#define PG8_BAR __builtin_amdgcn_s_barrier()
#define PG8_SCHED __builtin_amdgcn_sched_barrier(0)
    Unit cur, nxt; int ui = 0;
    if (!S.next(0, cur)) return;
    f32x4 acc[2][2][4][2];
#pragma unroll
    for (int a = 0; a < 2; ++a)
#pragma unroll
        for (int b = 0; b < 2; ++b)
#pragma unroll
            for (int m = 0; m < 4; ++m)
#pragma unroll
                for (int n = 0; n < 2; ++n) acc[a][b][m][n] = (f32x4){0.f, 0.f, 0.f, 0.f};
    bf16x8 At[4][2], B0[2][2], B1[2][2];
    const char* cA = (const char*)g.A + (size_t)cur.pm * tstepA; const char* cB = (const char*)g.Bt + (size_t)cur.pn * tstepB;
    if constexpr (SP2) {
        PG8_STAGE(PG8_SB(0, 0), cB, voffB); PG8_STAGE(PG8_SB(0, 1), cB + hstepB, voffB); PG8_STAGE(PG8_SA(0, 0), cA, voffA); PG8_STAGE(PG8_SA(0, 1), cA + hstepA, voffA);
        if (wr == 1) PG8_BAR;
        PG8_WAIT_V(2); PG8_BAR;
        PG8_STAGE(PG8_SB(1, 0), cB + kstep, voffB); PG8_STAGE(PG8_SA(1, 0), cA + kstep, voffA); PG8_STAGE(PG8_SB(1, 1), cB + hstepB + kstep, voffB);
        PG8_WAIT_V(6); PG8_BAR;
    } else {
        PG8_STAGE(PG8_SB(0, 0), cB, voffB); PG8_STAGE(PG8_SA(0, 0), cA, voffA); PG8_STAGE(PG8_SB(0, 1), cB + hstepB, voffB); PG8_STAGE(PG8_SA(0, 1), cA + hstepA, voffA);
        if (wr == 1) PG8_BAR;
        PG8_WAIT_V(4); PG8_BAR;
        PG8_STAGE(PG8_SB(1, 0), cB + kstep, voffB); PG8_STAGE(PG8_SA(1, 0), cA + kstep, voffA); PG8_STAGE(PG8_SB(1, 1), cB + hstepB + kstep, voffB);
        PG8_WAIT_V(6); PG8_BAR;
    }
    for (;;) {
        const bool has_next = S.next(ui + 1, nxt);
        const char* nA = has_next ? (const char*)g.A + (size_t)nxt.pm * tstepA : cA; const char* nB = has_next ? (const char*)g.Bt + (size_t)nxt.pn * tstepB : cB;
        for (int t = 0; t < nt; t += 2) {
            const bool last = (t == nt - 2);
            const char* a1 = cA + (size_t)(t + 1) * kstep;
            const char* a2 = last ? nA : cA + (size_t)(t + 2) * kstep; const char* b2 = last ? nB : cB + (size_t)(t + 2) * kstep;
            const char* a3 = a2 + kstep; const char* b3 = b2 + kstep;
            if constexpr (SP2) {
            PG8_LDB(B0, 0, 0); PG8_LDB(B1, 0, 1); PG8_SCHED; PG8_LDA(At, 0, 0); PG8_STAGE(PG8_SA(1, 1), a1 + hstepA, voffA);
            PG8_WAIT_V(8); PG8_WAIT_L(0); PG8_BAR; PG8_MMA(0, 0, At, B0); PG8_MMA(0, 1, At, B1); PG8_BAR; PG8_SCHED;
            PG8_LDA(At, 0, 1); PG8_STAGE(PG8_SB(0, 0), b2, voffB); PG8_STAGE(PG8_SB(0, 1), b2 + hstepB, voffB); PG8_STAGE(PG8_SA(0, 0), a2, voffA);
            PG8_WAIT_V(8); PG8_WAIT_L(0); PG8_BAR; PG8_MMA(1, 0, At, B0); PG8_MMA(1, 1, At, B1); PG8_BAR; PG8_SCHED;
            PG8_LDB(B0, 1, 0); PG8_LDB(B1, 1, 1); PG8_SCHED; PG8_LDA(At, 1, 0); PG8_STAGE(PG8_SA(0, 1), a2 + hstepA, voffA);
            PG8_WAIT_V(8); PG8_WAIT_L(0); PG8_BAR; PG8_MMA(0, 0, At, B0); PG8_MMA(0, 1, At, B1); PG8_BAR; PG8_SCHED;
            PG8_LDA(At, 1, 1); PG8_STAGE(PG8_SB(1, 0), b3, voffB); PG8_STAGE(PG8_SB(1, 1), b3 + hstepB, voffB); PG8_STAGE(PG8_SA(1, 0), a3, voffA);
            PG8_WAIT_V(8); PG8_WAIT_L(0); PG8_BAR; PG8_MMA(1, 0, At, B0); PG8_MMA(1, 1, At, B1); PG8_BAR; PG8_SCHED;
            } else {
            PG8_LDB(B0, 0, 0); PG8_SCHED; PG8_LDA(At, 0, 0); PG8_STAGE(PG8_SA(1, 1), a1 + hstepA, voffA);
            PG8_WAIT_L(8); PG8_BAR; PG8_WAIT_L(0); PG8_MMA(0, 0, At, B0); PG8_BAR; PG8_SCHED;
            PG8_LDB(B1, 0, 1); PG8_STAGE(PG8_SB(0, 0), b2, voffB);
            PG8_BAR; PG8_WAIT_L(0); PG8_MMA(0, 1, At, B1); PG8_BAR;
            PG8_LDA(At, 0, 1); PG8_STAGE(PG8_SA(0, 0), a2, voffA);
            PG8_BAR; PG8_WAIT_L(0); PG8_MMA(1, 0, At, B0); PG8_BAR; PG8_SCHED;
            PG8_STAGE(PG8_SB(0, 1), b2 + hstepB, voffB);
            PG8_WAIT_V(6); PG8_BAR; PG8_MMA(1, 1, At, B1); PG8_BAR;
            PG8_LDB(B0, 1, 0); PG8_SCHED; PG8_LDA(At, 1, 0); PG8_STAGE(PG8_SA(0, 1), a2 + hstepA, voffA);
            PG8_WAIT_L(8); PG8_BAR; PG8_WAIT_L(0); PG8_MMA(0, 0, At, B0); PG8_BAR; PG8_SCHED;
            PG8_LDB(B1, 1, 1); PG8_STAGE(PG8_SB(1, 0), b3, voffB);
            PG8_BAR; PG8_WAIT_L(0); PG8_MMA(0, 1, At, B1); PG8_BAR;
            PG8_LDA(At, 1, 1); PG8_STAGE(PG8_SA(1, 0), a3, voffA);
            PG8_BAR; PG8_WAIT_L(0); PG8_MMA(1, 0, At, B0); PG8_BAR; PG8_SCHED;
            PG8_STAGE(PG8_SB(1, 1), b3 + hstepB, voffB);
            PG8_WAIT_V(6); PG8_BAR; PG8_MMA(1, 1, At, B1); PG8_BAR;
            }
        }
        if constexpr (ALIGN_EPI) { if (wr == 0) PG8_BAR; }
        E(acc, cur, wr, wc, fr, fq);
        if (!has_next) break;
#pragma unroll
        for (int a = 0; a < 2; ++a)
#pragma unroll
            for (int b = 0; b < 2; ++b)
#pragma unroll
                for (int m = 0; m < 4; ++m)
#pragma unroll
                    for (int n = 0; n < 2; ++n) acc[a][b][m][n] = (f32x4){0.f, 0.f, 0.f, 0.f};
        cur = nxt; cA = nA; cB = nB; ++ui;
        if constexpr (ALIGN_EPI) { if (wr == 1) PG8_BAR; }
    }
    PG8_WAIT_V(0);
    if constexpr (!ALIGN_EPI) { if (wr == 0) PG8_BAR; }
    PG8_BAR;
#undef PG8_SA
#undef PG8_SB
#undef PG8_STAGE
#undef PG8_LDA
#undef PG8_LDB
#undef PG8_MMA
#undef PG8_WAIT_V
#undef PG8_WAIT_L
#undef PG8_BAR
#undef PG8_SCHED
}

typedef f32x4 AccT[2][2][4][2];
struct EpiP {
    static constexpr bool PERM = true;
    bf16_t* P; bf16_t* PC;
    __device__ __forceinline__ void operator()(const AccT& acc, const Unit& u, int wr, int wc, int fr, int fq) const {
        const int col0 = u.pn * BM + wc * 32 + 8 * fq;
#pragma unroll
        for (int ai = 0; ai < 2; ++ai)
#pragma unroll
            for (int m = 0; m < 4; ++m) {
                const int row = u.pm * BM + ai * HALF + wr * 64 + m * 16 + fr;
                bf16_t* rp = (row < NTOK) ? P + (size_t)row * LDP : PC + (size_t)(row - NTOK) * LDP;
#pragma unroll
                for (int bj = 0; bj < 2; ++bj) { const int col = col0 + bj * HALF;
                    if (col < LDP) { u32x4 o; o.x = pk2(acc[ai][bj][m][0][0], acc[ai][bj][m][0][1]); o.y = pk2(acc[ai][bj][m][0][2], acc[ai][bj][m][0][3]);
                        o.z = pk2(acc[ai][bj][m][1][0], acc[ai][bj][m][1][1]); o.w = pk2(acc[ai][bj][m][1][2], acc[ai][bj][m][1][3]); *(u32x4*)(rp + col) = o; } }
            }
    }
};
template <int SECOND> struct EpiU {
    static constexpr bool PERM = true;
    const bf16_t* P; bf16_t* U; int gcol;
    __device__ __forceinline__ void operator()(const AccT& acc, const Unit& u, int wr, int wc, int fr, int fq) const {
        const int col0 = u.pn * BM + wc * 32 + 8 * fq;
#pragma unroll
        for (int ai = 0; ai < 2; ++ai) {
            u32x4 gv[4][2], pv[4][2];
#pragma unroll
            for (int m = 0; m < 4; ++m) { const int row = u.pm * BM + ai * HALF + wr * 64 + m * 16 + fr;
#pragma unroll
                for (int bj = 0; bj < 2; ++bj) { const int col = col0 + bj * HALF; gv[m][bj] = *(const u32x4*)(P + (size_t)row * LDP + gcol + col);
                    if (SECOND) pv[m][bj] = *(const u32x4*)(U + (size_t)row * DM + col); } }
#pragma unroll
            for (int m = 0; m < 4; ++m) {
                const int row = u.pm * BM + ai * HALF + wr * 64 + m * 16 + fr;
#pragma unroll
                for (int bj = 0; bj < 2; ++bj) { const int col = col0 + bj * HALF;
                    float gf[8]; unpack8(gv[m][bj], gf);
                    float o[8];
#pragma unroll
                    for (int j = 0; j < 8; ++j) o[j] = sigmoidf_(gf[j]) * acc[ai][bj][m][j >> 2][j & 3];
                    bf16_t* up = U + (size_t)row * DM + col;
                    if (SECOND) { float pf[8]; unpack8(pv[m][bj], pf);
#pragma unroll
                        for (int j = 0; j < 8; ++j) o[j] += pf[j]; }
                    *(u32x4*)up = pack8(o); }
            }
        }
    }
};
struct EpiX1 {
    static constexpr bool PERM = true;
    const float* x; const float* mod; float* x1; float* rowsq;
    __device__ __forceinline__ void operator()(const AccT& acc, const Unit& u, int wr, int wc, int fr, int fq) const {
        const int col0 = u.pn * BM + wc * 32 + 8 * fq;
        const int b = (u.pm * BM) >> 13;
        f32x4 gq[2][2];
#pragma unroll
        for (int bj = 0; bj < 2; ++bj)
#pragma unroll
            for (int n = 0; n < 2; ++n) gq[bj][n] = *(const f32x4*)(mod + b * 12288 + 2 * DM + col0 + bj * HALF + 4 * n);
#pragma unroll
        for (int am = 0; am < 4; ++am) { const int ai = am >> 1, m0 = (am & 1) * 2;
            f32x4 xq[2][2][2];
#pragma unroll
            for (int mm = 0; mm < 2; ++mm) { const int row = u.pm * BM + ai * HALF + wr * 64 + (m0 + mm) * 16 + fr;
#pragma unroll
                for (int bj = 0; bj < 2; ++bj)
#pragma unroll
                    for (int n = 0; n < 2; ++n) xq[mm][bj][n] = *(const f32x4*)(x + (size_t)row * DM + col0 + bj * HALF + 4 * n); }
#pragma unroll
            for (int mm = 0; mm < 2; ++mm) { const int m = m0 + mm;
                const int row = u.pm * BM + ai * HALF + wr * 64 + m * 16 + fr;
                float ss = 0.f;
#pragma unroll
                for (int bj = 0; bj < 2; ++bj) { const int col = col0 + bj * HALF;
#pragma unroll
                    for (int n = 0; n < 2; ++n) { f32x4 o = xq[mm][bj][n] + gq[bj][n] * acc[ai][bj][m][n]; *(f32x4*)(x1 + (size_t)row * DM + col + 4 * n) = o;
                        ss += o[0] * o[0] + o[1] * o[1] + o[2] * o[2] + o[3] * o[3]; } }
                ss += __shfl_xor(ss, 16); ss += __shfl_xor(ss, 32);
                if (fq == 0) rowsq[(size_t)(u.pn * 4 + wc) * NTOK + row] = ss;
            }
        }
    }
};
struct EpiQ {
    static constexpr bool PERM = true;
    bf16_t* O;
    __device__ __forceinline__ void operator()(const AccT& acc, const Unit& u, int wr, int wc, int fr, int fq) const {
        const int col0 = u.pn * BM + wc * 32 + 8 * fq;
#pragma unroll
        for (int ai = 0; ai < 2; ++ai)
#pragma unroll
            for (int m = 0; m < 4; ++m) {
                const int row = u.pm * BM + ai * HALF + wr * 64 + m * 16 + fr;
#pragma unroll
                for (int bj = 0; bj < 2; ++bj) { const int col = col0 + bj * HALF; u32x4 o;
                    o.x = pk2(acc[ai][bj][m][0][0], acc[ai][bj][m][0][1]); o.y = pk2(acc[ai][bj][m][0][2], acc[ai][bj][m][0][3]);
                    o.z = pk2(acc[ai][bj][m][1][0], acc[ai][bj][m][1][1]); o.w = pk2(acc[ai][bj][m][1][2], acc[ai][bj][m][1][3]);
                    *(u32x4*)(O + (size_t)row * DM + col) = o; }
            }
    }
};
}

#define XB_TMO      128
#define XB_XCNT(j)  (256  + 64 * (j))
#define XB_XSUB(j)  (1280 + 64 * (j))
#define XB_XGEN(j)  (2304 + 64 * (j))
#define XB_TOP      3328
#define XB_TOPGEN   3392
#define XCD_BAR_WORDS 3456
#define XB_SPIN_CAP (1u << 20)
__device__ __forceinline__ unsigned xb_ld(unsigned* p)              { return __hip_atomic_load(p, __ATOMIC_RELAXED, __HIP_MEMORY_SCOPE_AGENT); }
__device__ __forceinline__ unsigned xb_add(unsigned* p, unsigned v) { return __hip_atomic_fetch_add(p, v, __ATOMIC_RELAXED, __HIP_MEMORY_SCOPE_AGENT); }
__device__ __forceinline__ unsigned xb_xcc_id() { return (unsigned)__builtin_amdgcn_s_getreg((3 << 11) | 20) & 0xFu; }
#define XB_SPIN(cond, bar) do { unsigned _sp = 0; while (cond) { __builtin_amdgcn_s_sleep(1); \
    if ((++_sp & 255u) == 0u) { if (xb_ld(&(bar)[XB_TMO])) break; if (_sp > XB_SPIN_CAP) { atomicAdd(&(bar)[XB_TMO], 1u); break; } } } } while (0)
struct XcdBarrier { unsigned* bar; unsigned x; volatile LAS unsigned* st; };
__device__ __forceinline__ XcdBarrier xcd_barrier_post(unsigned* bar, volatile LAS unsigned* st) {
    XcdBarrier b; b.bar = bar; b.x = xb_xcc_id(); b.st = st;
    if (threadIdx.x == 0) (void)xb_add(&bar[XB_XCNT(b.x)], 1u);
    return b;
}
__device__ __forceinline__ void xcd_barrier_complete(unsigned* bar, unsigned x, unsigned& nloc, unsigned& nx) {
    const unsigned G = gridDim.x * gridDim.y * gridDim.z;
    unsigned sum, cnt, mine, sp = 0u;
    for (;;) {
        sum = 0u; cnt = 0u; mine = 0u;
#pragma unroll
        for (unsigned j = 0; j < 16; ++j) { const unsigned c = xb_ld(&bar[XB_XCNT(j)]); sum += c; cnt += (c > 0u) ? 1u : 0u; mine = (j == x) ? c : mine; }
        if (sum == G) break;
        __builtin_amdgcn_s_sleep(1);
        if ((++sp & 255u) == 0u) { if (xb_ld(&bar[XB_TMO])) break; if (sp > XB_SPIN_CAP) { atomicAdd(&bar[XB_TMO], 1u); break; } }
    }
    nloc = mine > 0u ? mine : 1u; nx = cnt > 0u ? cnt : 1u;
}
__device__ __forceinline__ void xcd_barrier(const XcdBarrier& b) {
    asm volatile("s_waitcnt vmcnt(0)" ::: "memory");
    __syncthreads();
    if (threadIdx.x == 0) {
        unsigned* bar = b.bar;
        __builtin_amdgcn_s_waitcnt(0);
        unsigned nloc = b.st[0], nx = b.st[1];
        if (nloc == 0u) { xcd_barrier_complete(bar, b.x, nloc, nx); b.st[0] = nloc; b.st[1] = nx; }
        const unsigned old = xb_add(&bar[XB_XSUB(b.x)], 1u);
        const unsigned gen = old / nloc;
        if (old + 1u == (gen + 1u) * nloc) {
            __builtin_amdgcn_fence(__ATOMIC_RELEASE, "agent");
            asm volatile("s_waitcnt vmcnt(0)" ::: "memory");
            const unsigned og = xb_add(&bar[XB_TOP], 1u);
            const unsigned tg = og / nx;
            if (og + 1u == (tg + 1u) * nx) xb_add(&bar[XB_TOPGEN], 1u);
            else XB_SPIN(xb_ld(&bar[XB_TOPGEN]) == tg, bar);
            __builtin_amdgcn_fence(__ATOMIC_ACQUIRE, "agent");
            xb_add(&bar[XB_XGEN(b.x)], 1u);
            asm volatile("s_waitcnt vmcnt(0)" ::: "memory");
        } else {
            XB_SPIN(xb_ld(&bar[XB_XGEN(b.x)]) == gen, bar);
            __builtin_amdgcn_fence(__ATOMIC_ACQUIRE, "agent");
            asm volatile("s_waitcnt vmcnt(0)" ::: "memory");
        }
    }
    __syncthreads();
}

template <int MB, int NBK>
__device__ __forceinline__ void wave_mma(f32x4 (&acc)[MB][NBK], const LAS unsigned char* A, int lda_b, const LAS unsigned char* Bt, int ldb_b, int K, int lane) {
    const int r = lane & 15, q = lane >> 4;
    const LAS unsigned char* ap = A + r * lda_b + q * 16;
    const LAS unsigned char* bp = Bt + r * ldb_b + q * 16;
#pragma unroll 1
    for (int k0 = 0; k0 < K; k0 += 32) {
        bf16x8 a[MB];
#pragma unroll
        for (int mb = 0; mb < MB; ++mb) a[mb] = *(const LAS bf16x8*)(ap + mb * 16 * lda_b + k0 * 2);
#pragma unroll
        for (int nb = 0; nb < NBK; ++nb) { const bf16x8 b = *(const LAS bf16x8*)(bp + nb * 16 * ldb_b + k0 * 2);
#pragma unroll
            for (int mb = 0; mb < MB; ++mb) acc[mb][nb] = __builtin_amdgcn_mfma_f32_16x16x32_bf16(a[mb], b, acc[mb][nb], 0, 0, 0); }
    }
}

struct Args { const float* in[20]; float* out; unsigned char* ws; int ph_lo, ph_hi; };

#define IN_X 0
#define IN_C 1
#define IN_CTX 2
#define IN_CCTX 3
#define IN_WADA 4
#define IN_BADA 5
#define IN_N1G 6
#define IN_WIN 7
#define IN_RDEC 8
#define IN_MCONV 9
#define IN_MGB 10
#define IN_WRO 11
#define IN_WMO 12
#define IN_WO 13
#define IN_N2G 14
#define IN_PQ 15
#define IN_PK 16
#define IN_PD 17
#define IN_PU 18
#define IN_FG 19

template <int MODE>
__device__ __forceinline__ void transpose_item(const float* W, int K, int N, int Npad, bf16_t* WT, LAS float* scr, int item, int lane) {
    const int nblk = Npad / 32, kb = item / nblk, nb = item % nblk, k0 = 64 * kb, n0 = 32 * nb;
    const int n = n0 + (lane & 31);
    int src = n;
    if (MODE == 1) { src = (n < 6144) ? n : (n < 10240 ? n + 16 : (n < 10256 ? n - 10240 + 6144 : -1)); }
#pragma unroll 8
    for (int i = 0; i < 32; ++i) { const int kk = 2 * i + (lane >> 5); scr[kk * 33 + (lane & 31)] = (src >= 0) ? W[(size_t)(k0 + kk) * N + src] : 0.f; }
    LDS_WAIT(); asm volatile("" ::: "memory");
    const int c = lane & 7;
#pragma unroll
    for (int j = 0; j < 4; ++j) { const int nn = (lane >> 3) + 8 * j; const LAS float* s = scr + (8 * c) * 33 + nn;
        u32x4 o; o.x = pk2(s[0 * 33], s[1 * 33]); o.y = pk2(s[2 * 33], s[3 * 33]); o.z = pk2(s[4 * 33], s[5 * 33]); o.w = pk2(s[6 * 33], s[7 * 33]);
        *(u32x4*)(WT + (size_t)(n0 + nn) * K + k0 + 8 * c) = o; }
    LDS_WAIT(); asm volatile("" ::: "memory");
}

__device__ __forceinline__ u32x4 ld16(const bf16_t* p) { return *(const u32x4*)p; }
__device__ __forceinline__ void conv8(const bf16_t* base  , int t, int Ls, const float* w0, const float* w1, const float* w2, float* out) {
    float c[8], p[8], n[8];
    unpack8(ld16(base + (size_t)t * LDP), c);
    if (t > 0) unpack8(ld16(base + (size_t)(t - 1) * LDP), p); else { for (int j = 0; j < 8; ++j) p[j] = 0.f; }
    if (t < Ls - 1) unpack8(ld16(base + (size_t)(t + 1) * LDP), n); else { for (int j = 0; j < 8; ++j) n[j] = 0.f; }
#pragma unroll
    for (int j = 0; j < 8; ++j) { const float pre = w0[j] * p[j] + w1[j] * c[j] + w2[j] * n[j]; out[j] = pre * sigmoidf_(pre); }
}
__device__ __forceinline__ void conv8r(const u32x4 rp, const u32x4 rc, const u32x4 rn, const float* w0, const float* w1, const float* w2, float* out) {
    float c[8], p[8], n[8]; unpack8(rc, c); unpack8(rp, p); unpack8(rn, n);
#pragma unroll
    for (int j = 0; j < 8; ++j) { const float pre = w0[j] * p[j] + w1[j] * c[j] + w2[j] * n[j]; out[j] = pre * sigmoidf_(pre); }
}
__device__ __forceinline__ void conv_rows(const bf16_t* base, int t0, int s0, int Ls, u32x4 (&rows)[4][3]) {
    const u32x4 z = {0u, 0u, 0u, 0u};
#pragma unroll
    for (int i = 0; i < 4; ++i) { const int t = t0 + s0 + 32 * i;
        rows[i][1] = ld16(base + (size_t)t * LDP);
        rows[i][0] = (t > 0) ? ld16(base + (size_t)(t - 1) * LDP) : z;
        rows[i][2] = (t < Ls - 1) ? ld16(base + (size_t)(t + 1) * LDP) : z; }
}
__device__ __forceinline__ void ldw8(const float* p, float* w) { const f32x4 a = *(const f32x4*)p, b = *(const f32x4*)(p + 4); w[0] = a[0]; w[1] = a[1]; w[2] = a[2]; w[3] = a[3]; w[4] = b[0]; w[5] = b[1]; w[6] = b[2]; w[7] = b[3]; }

__device__ __forceinline__ void scan128_sum_prefix(float& lo, float& hi, int lane) {
#pragma unroll
    for (int o = 1; o < 64; o <<= 1) { const float a = __shfl_up(lo, o), b = __shfl_up(hi, o); if (lane >= o) { lo += a; hi += b; } }
    hi += __shfl(lo, 63);
}
__device__ __forceinline__ void scan128_sum_suffix(float& lo, float& hi, int lane) {
#pragma unroll
    for (int o = 1; o < 64; o <<= 1) { const float a = __shfl_down(lo, o), b = __shfl_down(hi, o); if (lane + o < 64) { lo += a; hi += b; } }
    lo += __shfl(hi, 0);
}
__device__ __forceinline__ void scan128_max_prefix(float& lo, float& hi, int lane) {
#pragma unroll
    for (int o = 1; o < 64; o <<= 1) { const float a = __shfl_up(lo, o), b = __shfl_up(hi, o); if (lane >= o) { lo = fmaxf(lo, a); hi = fmaxf(hi, b); } }
    hi = fmaxf(hi, __shfl(lo, 63));
}
__device__ __forceinline__ void scan128_max_suffix(float& lo, float& hi, int lane) {
#pragma unroll
    for (int o = 1; o < 64; o <<= 1) { const float a = __shfl_down(lo, o), b = __shfl_down(hi, o); if (lane + o < 64) { lo = fmaxf(lo, a); hi = fmaxf(hi, b); } }
    lo = fmaxf(lo, __shfl(hi, 0));
}

__device__ __forceinline__ float gelu_erf(float v) { return 0.5f * v * (1.f + erff(v * 0.70710678118654752f)); }

__device__ __forceinline__ float fmix_lo(float w, unsigned h2, float acc) { asm("v_fma_mix_f32 %0, %1, %2, %0 op_sel:[0,0,0] op_sel_hi:[0,1,0]" : "+v"(acc) : "v"(w), "v"(h2)); return acc; }
__device__ __forceinline__ float fmix_hi(float w, unsigned h2, float acc) { asm("v_fma_mix_f32 %0, %1, %2, %0 op_sel:[0,1,0] op_sel_hi:[0,1,0]" : "+v"(acc) : "v"(w), "v"(h2)); return acc; }
#define EBLK(e) ((((unsigned)(e) >> 7) ^ (unsigned)(e)) & 15u)
#define EROWIN(e) ((((unsigned)(e) >> 7) << 3) | (((unsigned)(e) & 127u) >> 4))
#define EROW(ebv, r) ((((r) >> 3) << 7) + (((r) & 7) << 4) + ((((ebv) ^ ((r) >> 3))) & 15))
__device__ __forceinline__ void ins16(float (&L)[16], float x) {
#pragma unroll
    for (int j = 15; j >= 1; --j) L[j] = __builtin_amdgcn_fmed3f(L[j - 1], L[j], x);
    L[0] = fmaxf(L[0], x);
}

__global__ void __launch_bounds__(NTHR, 2) fwd_kernel(Args args) {
    extern __shared__ __attribute__((aligned(16))) unsigned char lds_raw[];
    LAS unsigned char* lds = (LAS unsigned char*)lds_raw;
    const int tid = threadIdx.x, lane = tid & 63, wave = __builtin_amdgcn_readfirstlane(tid >> 6);
    const int G = gridDim.x, bx = blockIdx.x;
    const int gw = bx * NWAVES + wave, NGW = G * NWAVES;
    const int gt = bx * NTHR + tid, NGT = G * NTHR;
    unsigned char* ws = args.ws;
    const int lo = args.ph_lo, hi = args.ph_hi;

    volatile LAS unsigned* MISC = (volatile LAS unsigned*)(lds + LDS_MISC);
    XcdBarrier bar; bar.bar = (unsigned*)(ws + WS_CTL); bar.x = 0; bar.st = MISC;
    const bool fused = (hi - lo) > 1;
    if (fused) {
        if (tid < 4) MISC[tid] = 0u;
        __syncthreads();
        bar = xcd_barrier_post((unsigned*)(ws + WS_CTL), MISC);
    }
#ifndef PH_MASK
#define PH_MASK 0x7FFF
#endif
#define IN(k) (((PH_MASK >> (k)) & 1) && lo <= (k) && (k) < hi)
#ifndef REPEAT_MASK
#define REPEAT_MASK 0
#endif
#define NREP(k) ((((REPEAT_MASK) >> (k)) & 1) ? 2 : 1)
#ifndef VAR_NODMA
#define VAR_NODMA 0
#endif
#ifndef VAR_NOCOMP
#define VAR_NOCOMP 0
#endif
#ifndef VAR_NOAUX
#define VAR_NOAUX 0
#endif
#define VARON(k, f) ((f) && NREP(k) == 2 && rep_ == 0)
#define SEAM(k) do { if (IN(k) && IN((k) + 1)) { if ((k) == 0) { cg::this_grid().sync(); } else { xcd_barrier(bar); } } } while (0)

    float* MOD = (float*)(ws + WS_MOD);
    float* ROTC = (float*)(ws + WS_ROTC); float* ROTS = (float*)(ws + WS_ROTS);
    bf16_t* P = (bf16_t*)(ws + WS_P); bf16_t* PC = (bf16_t*)(ws + WS_PCTX);

    for (int rep_ = 0; rep_ < NREP(0); ++rep_) { if (rep_) xcd_barrier(bar);
    if (IN(0)) {
        const float* c = args.in[IN_C]; const float* cctx = args.in[IN_CCTX]; const float* wada = args.in[IN_WADA]; const float* bada = args.in[IN_BADA];
        LAS float* sc = (LAS float*)lds;
        LAS float* red = (LAS float*)(lds + 40960);
        if (bx < 192) {
            for (int i = tid; i < 5 * DM; i += NTHR) { const float v = (i < 4 * DM) ? c[i] : cctx[i - 4 * DM]; sc[i] = v * sigmoidf_(v); }
            __syncthreads();
        }
        for (int u = bx; u < 192; u += G) {
            const int rg = tid >> 4, cq = tid & 15;
            f32x4 acc[5];
#pragma unroll
            for (int r = 0; r < 5; ++r) acc[r] = (f32x4){0.f, 0.f, 0.f, 0.f};
            for (int k = rg; k < DM; k += 32) { const f32x4 w = *(const f32x4*)(wada + (size_t)k * 12288 + 64 * u + 4 * cq);
#pragma unroll
                for (int r = 0; r < 5; ++r) acc[r] += w * sc[r * DM + k]; }
#pragma unroll
            for (int r = 0; r < 5; ++r)
#pragma unroll
                for (int j = 0; j < 4; ++j) red[(rg * 5 + r) * 64 + 4 * cq + j] = acc[r][j];
            __syncthreads();
            if (tid < 320) { const int r = tid >> 6, j = tid & 63; float s = bada[64 * u + j];
                for (int g2 = 0; g2 < 32; ++g2) s += red[(g2 * 5 + r) * 64 + j];
                MOD[r * 12288 + 64 * u + j] = s; }
            __syncthreads();
        }
        __syncthreads();
        LAS float* scr = (LAS float*)(lds + wave * 16384);
        constexpr int I_IN = 32 * (NPADW / 32), I_RO = 16 * 64, I_O = 32 * 64;
        constexpr int NITEMS = I_IN + 2 * I_RO + 2 * I_O;
        for (int it = gw; it < NITEMS; it += NGW) {
            int r = it;
            if (r < I_IN) { transpose_item<1>(args.in[IN_WIN], DM, LDP, NPADW, (bf16_t*)(ws + WS_WINT), scr, r, lane); continue; } r -= I_IN;
            if (r < I_RO) { transpose_item<0>(args.in[IN_WRO], 1024, DM, DM, (bf16_t*)(ws + WS_WRO), scr, r, lane); continue; } r -= I_RO;
            if (r < I_RO) { transpose_item<0>(args.in[IN_WMO], 1024, DM, DM, (bf16_t*)(ws + WS_WMO), scr, r, lane); continue; } r -= I_RO;
            if (r < I_O) { transpose_item<0>(args.in[IN_WO], DM, DM, DM, (bf16_t*)(ws + WS_WO), scr, r, lane); continue; } r -= I_O;
            transpose_item<0>(args.in[IN_PQ], DM, DM, DM, (bf16_t*)(ws + WS_WQ), scr, r, lane);
        }
        { const float* pk = args.in[IN_PK]; bf16_t* k16 = (bf16_t*)(ws + WS_KEYS);
          for (int i = gt; i < 262144 / 8; i += NGT) { const f32x4 a = *(const f32x4*)(pk + (size_t)i * 8), b = *(const f32x4*)(pk + (size_t)i * 8 + 4);
              u32x4 o; o.x = pk2(a[0], a[1]); o.y = pk2(a[2], a[3]); o.z = pk2(b[0], b[1]); o.w = pk2(b[2], b[3]); *(u32x4*)(k16 + (size_t)i * 8) = o; } }
        for (int i = gt; i < SEQ * 32; i += NGT) { const int t = i >> 5, ii = i & 31, a = ii & 15;
            const float freq = powf(10000.f, -(float)a / 16.f); const float pos = (ii < 16) ? (float)(t >> 6) : (float)(t & 63); const float ang = pos * freq;
            ROTC[i] = cosf(ang); ROTS[i] = sinf(ang); }
    }
    }
    SEAM(0);

    for (int rep_ = 0; rep_ < NREP(1); ++rep_) { if (rep_) xcd_barrier(bar);
    if (IN(1)) {
        const float* x = args.in[IN_X]; const float* ctx = args.in[IN_CTX]; const float* g1 = args.in[IN_N1G]; bf16_t* H1 = (bf16_t*)(ws + WS_H1);
        for (int row = gw; row < MROWS; row += NGW) {
            const float* src = (row < NTOK) ? x + (size_t)row * DM : ctx + (size_t)(row - NTOK) * DM; const int r = (row < NTOK) ? (row >> 13) : 4;
            f32x4 v[8]; float ss = 0.f;
#pragma unroll
            for (int j = 0; j < 8; ++j) { v[j] = *(const f32x4*)(src + 4 * (lane + 64 * j)); ss += v[j][0] * v[j][0] + v[j][1] * v[j][1] + v[j][2] * v[j][2] + v[j][3] * v[j][3]; }
            const float rstd = rsqrtf(wave_sum(ss) * (1.f / DM) + 1e-6f);
            const float* shp = MOD + r * 12288; const float* scp = shp + DM;
#pragma unroll
            for (int j = 0; j < 8; ++j) { const int idx = 4 * (lane + 64 * j); const f32x4 g = *(const f32x4*)(g1 + idx), sh = *(const f32x4*)(shp + idx), sc = *(const f32x4*)(scp + idx);
                const f32x4 h = v[j] * rstd * g * (sc + 1.f) + sh; u32x2 o; o.x = pk2(h[0], h[1]); o.y = pk2(h[2], h[3]); *(u32x2*)(H1 + (size_t)row * DM + idx) = o; }
        }
    }
    }
    SEAM(1);

    for (int rep_ = 0; rep_ < NREP(2); ++rep_) { if (rep_) xcd_barrier(bar);
    if (IN(2)) {
        pg8::Gemm g{(const bf16_t*)(ws + WS_H1), (const bf16_t*)(ws + WS_WINT), DM, DM}; pg8::OrderG1 S{G, bx}; pg8::EpiP E{P, PC};
        pg8::gemm_phase<pg8::EpiP, pg8::OrderG1>(lds, g, S, E);
    }
    }
    SEAM(2);

    const float* rdec = args.in[IN_RDEC]; const float* mconv = args.in[IN_MCONV]; const float* mgb = args.in[IN_MGB];
    bf16_t* RST = (bf16_t*)(ws + WS_RST); bf16_t* MST = (bf16_t*)(ws + WS_MST);
    float* MSCAL = (float*)(ws + WS_MSCAL); float* MPREV = (float*)(ws + WS_MPREV); float* NLOC = (float*)(ws + WS_NLOC); float* NPREV = (float*)(ws + WS_NPREV);

    for (int rep_ = 0; rep_ < NREP(3); ++rep_) { if (rep_) xcd_barrier(bar);
    if (IN(3)) {
        for (int u = bx; u < 1056 + 2112; u += G) {
            int tid = threadIdx.x; asm volatile("" : "+v"(tid)); const int lane = tid & 63;
            if (u < 1056) {
                const int bh = u / 66, cc = u % 66, b = bh >> 2, h = bh & 3;
                const bool ctxu = cc >= 64; const int Ls = ctxu ? CTXL : SEQ; const int t0 = ctxu ? (cc - 64) * 128 : cc * 128;
                const bf16_t* Pb = ctxu ? PC + (size_t)(b * CTXL) * LDP : P + (size_t)(b * SEQ) * LDP;
                LAS unsigned char* KWT = lds;
                LAS unsigned char* VT = lds + 69632;
                LAS float* WTS = (LAS float*)(lds + 104448);
                if (wave < 2) {
                    const int dir = wave;
                    const float bi = mgb[dir * 8 + h], bfv = mgb[dir * 8 + 4 + h];
                    const bf16_t* gp = Pb + (size_t)t0 * LDP + C_MG + dir * 8 + h;
                    const float i_lo = bf2f(gp[(size_t)lane * LDP]) + bi, i_hi = bf2f(gp[(size_t)(lane + 64) * LDP]) + bi;
                    const float f_lo = logsigf_(bf2f(gp[(size_t)lane * LDP + 4]) + bfv), f_hi = logsigf_(bf2f(gp[(size_t)(lane + 64) * LDP + 4]) + bfv);
                    float c_lo = f_lo, c_hi = f_hi, bend;
                    if (dir == 0) { scan128_sum_prefix(c_lo, c_hi, lane); bend = __shfl(c_hi, 63); }
                    else { scan128_sum_suffix(c_lo, c_hi, lane); bend = __shfl(c_lo, 0); }
                    const float w_lo = bend - c_lo + i_lo, w_hi = bend - c_hi + i_hi;
                    const float M = wave_max(fmaxf(w_lo, w_hi));
                    WTS[dir * 128 + lane] = __expf(w_lo - M); WTS[dir * 128 + 64 + lane] = __expf(w_hi - M);
                    if (lane == 0) { MSCAL[((dir * 16 + bh) * 66 + cc) * 2] = M; MSCAL[((dir * 16 + bh) * 66 + cc) * 2 + 1] = bend; }
                }
                __syncthreads();
                {   const int ch = (tid >> 5) * 8, s0 = tid & 31;
                    float w0[8], w1[8], w2[8]; const float* wp = mconv + 512 + h * 128 + ch; ldw8(wp, w0); ldw8(wp + 1024, w1); ldw8(wp + 2048, w2);
                    u32x4 rows[4][3]; conv_rows(Pb + C_MK + h * 128 + ch, t0, s0, Ls, rows);
#pragma unroll
                    for (int i = 0; i < 4; ++i) { const int s = s0 + 32 * i; float kv[8]; conv8r(rows[i][0], rows[i][1], rows[i][2], w0, w1, w2, kv);
                        const float wf = WTS[s] * 0.08838834764831845f, wb = WTS[128 + s] * 0.08838834764831845f;
#pragma unroll
                        for (int j = 0; j < 8; ++j) { *(LAS bf16_t*)(KWT + ((ch + j) * 136 + s) * 2) = f2bf(kv[j] * wf); *(LAS bf16_t*)(KWT + ((128 + ch + j) * 136 + s) * 2) = f2bf(kv[j] * wb); } } }
#pragma unroll 1
                for (int half = 0; half < 2; ++half) {
                    __syncthreads();
                    { u32x4 raw_[4];
#pragma unroll
                    for (int i = 0; i < 4; ++i) { const int task = tid + NTHR * i, s = task & 127, e8 = (task >> 7) * 8; raw_[i] = ld16(Pb + (size_t)(t0 + s) * LDP + C_MV + h * 256 + half * 128 + e8); }
#pragma unroll
                    for (int i = 0; i < 4; ++i) { const int task = tid + NTHR * i, s = task & 127, e8 = (task >> 7) * 8; const u32x4 v = raw_[i];
#pragma unroll
                        for (int j = 0; j < 4; ++j) { *(LAS bf16_t*)(VT + ((e8 + 2 * j) * 136 + s) * 2) = (bf16_t)(v[j] & 0xffffu); *(LAS bf16_t*)(VT + ((e8 + 2 * j + 1) * 136 + s) * 2) = (bf16_t)(v[j] >> 16); } } }
                    __syncthreads();
                    if (half == 0 && tid < 256) { float s = 0.f; const LAS bf16_t* rp = (const LAS bf16_t*)(KWT + tid * 272);
                        for (int k = 0; k < 128; ++k) s += bf2f(rp[k]);
                        NLOC[(((tid >> 7) * 16 + bh) * 66 + cc) * 128 + (tid & 127)] = s; }
                    f32x4 acc[2][8];
#pragma unroll
                    for (int a = 0; a < 2; ++a)
#pragma unroll
                        for (int n = 0; n < 8; ++n) acc[a][n] = (f32x4){0.f, 0.f, 0.f, 0.f};
                    {   f32x4 (&a0)[1][8] = *reinterpret_cast<f32x4 (*)[1][8]>(&acc[0]); f32x4 (&a1)[1][8] = *reinterpret_cast<f32x4 (*)[1][8]>(&acc[1]);
                        wave_mma<1, 8>(a0, KWT + (16 * wave) * 272, 272, VT, 272, 128, lane);
                        wave_mma<1, 8>(a1, KWT + (128 + 16 * wave) * 272, 272, VT, 272, 128, lane); }
                    const int r = lane & 15, q = lane >> 4;
#pragma unroll
                    for (int dir = 0; dir < 2; ++dir)
#pragma unroll
                        for (int nb = 0; nb < 8; ++nb) { const int e = half * 128 + nb * 16 + r, d = 16 * wave + q * 4;
                            u32x2 o; o.x = pk2(acc[dir][nb][0], acc[dir][nb][1]); o.y = pk2(acc[dir][nb][2], acc[dir][nb][3]);
                            *(u32x2*)(MST + ((size_t)((dir * 16 + bh) * 66 + cc) * 256 + e) * 128 + d) = o; }
                }
                __syncthreads();
            } else {
                const int v = u - 1056; const int bh = v / 66, cc = v % 66, b = bh >> 3, h = bh & 7;
                const bool ctxu = cc >= 64; const int t0 = ctxu ? (cc - 64) * 128 : cc * 128;
                const bf16_t* Pb = ctxu ? PC + (size_t)(b * CTXL) * LDP : P + (size_t)(b * SEQ) * LDP;
                LAS unsigned char* KT = lds;
                LAS unsigned char* VT = lds + 34816;
                const float lgf = logsigf_(rdec[h]), lgb = logsigf_(rdec[8 + h]);
                { u32x4 raw_[4];
#pragma unroll
                for (int i = 0; i < 4; ++i) { const int task = tid + NTHR * i, s = task & 127, e8 = (task >> 7) * 8; raw_[i] = ld16(Pb + (size_t)(t0 + s) * LDP + C_RV + h * 128 + e8); }
#pragma unroll
                for (int i = 0; i < 4; ++i) { const int task = tid + NTHR * i, s = task & 127, e8 = (task >> 7) * 8; const u32x4 vv = raw_[i];
#pragma unroll
                    for (int j = 0; j < 4; ++j) { *(LAS bf16_t*)(VT + ((e8 + 2 * j) * 136 + s) * 2) = (bf16_t)(vv[j] & 0xffffu); *(LAS bf16_t*)(VT + ((e8 + 2 * j + 1) * 136 + s) * 2) = (bf16_t)(vv[j] >> 16); } } }
                {   const int s = tid & 127, ic = (tid >> 7) * 8; float k1[8], k2[8];
                    const bf16_t* kp = Pb + (size_t)(t0 + s) * LDP + C_RK + h * 64 + ic; unpack8(ld16(kp), k1); unpack8(ld16(kp + 32), k2);
                    const float df = __expf(lgf * (float)(127 - s)) * 0.125f, db = __expf(lgb * (float)s) * 0.125f;
#pragma unroll
                    for (int j = 0; j < 8; ++j) { float r1 = k1[j], r2 = k2[j];
                        if (!ctxu) { const float cs = ROTC[(t0 + s) * 32 + ic + j], sn = ROTS[(t0 + s) * 32 + ic + j]; r1 = k1[j] * cs - k2[j] * sn; r2 = k2[j] * cs + k1[j] * sn; }
                        *(LAS bf16_t*)(KT + ((ic + j) * 136 + s) * 2) = f2bf(r1 * df); *(LAS bf16_t*)(KT + ((32 + ic + j) * 136 + s) * 2) = f2bf(r2 * df);
                        *(LAS bf16_t*)(KT + ((64 + ic + j) * 136 + s) * 2) = f2bf(r1 * db); *(LAS bf16_t*)(KT + ((96 + ic + j) * 136 + s) * 2) = f2bf(r2 * db); } }
                __syncthreads();
                f32x4 acc[1][8];
#pragma unroll
                for (int n = 0; n < 8; ++n) acc[0][n] = (f32x4){0.f, 0.f, 0.f, 0.f};
                wave_mma<1, 8>(acc, KT + (16 * wave) * 272, 272, VT, 272, 128, lane);
                const int r = lane & 15, q = lane >> 4, dir = wave >> 2, d = ((16 * wave) & 63) + q * 4;
#pragma unroll
                for (int nb = 0; nb < 8; ++nb) { const int e = nb * 16 + r; u32x2 o; o.x = pk2(acc[0][nb][0], acc[0][nb][1]); o.y = pk2(acc[0][nb][2], acc[0][nb][3]);
                    *(u32x2*)(RST + ((size_t)((dir * 32 + bh) * 66 + cc) * 128 + e) * 64 + d) = o; }
                __syncthreads();
            }
        }
    }
    }
    SEAM(3);

    for (int rep_ = 0; rep_ < NREP(4); ++rep_) { if (rep_) xcd_barrier(bar);
    if (IN(4)) {
        for (int task = gt; task < 65536; task += NGT) {
            const int dc = task & 7, e = (task >> 3) & 127, bh = (task >> 10) & 31, dir = task >> 15, h = bh & 7;
            const float g = expf(128.f * logsigf_(rdec[dir * 8 + h]));
            bf16_t* base = RST + (size_t)((dir * 32 + bh) * 66) * 8192 + e * 64 + dc * 8;
            float S[8], v[8];
#pragma unroll
            for (int j = 0; j < 8; ++j) S[j] = 0.f;
            for (int k = 0; k < 2; ++k) { const int cc = dir ? (65 - k) : (64 + k); unpack8(ld16(base + (size_t)cc * 8192), v);
#pragma unroll
                for (int j = 0; j < 8; ++j) S[j] = g * S[j] + v[j]; }
#pragma unroll 1
            for (int kb = 0; kb < 64; kb += 8) { u32x4 raw[8];
#pragma unroll
                for (int kk = 0; kk < 8; ++kk) { const int c = dir ? (63 - kb - kk) : (kb + kk); raw[kk] = ld16(base + (size_t)c * 8192); }
#pragma unroll
                for (int kk = 0; kk < 8; ++kk) { const int c = dir ? (63 - kb - kk) : (kb + kk); unpack8(raw[kk], v); *(u32x4*)(base + (size_t)c * 8192) = pack8(S);
#pragma unroll
                    for (int j = 0; j < 8; ++j) S[j] = g * S[j] + v[j]; } }
        }
        for (int task = gt; task < 131072; task += NGT) {
            const int dc = task & 15, e = (task >> 4) & 255, bh = (task >> 12) & 15, dir = task >> 16;
            bf16_t* base = MST + (size_t)((dir * 16 + bh) * 66) * 32768 + e * 128 + dc * 8;
            const float* scp = MSCAL + (size_t)((dir * 16 + bh) * 66) * 2;
            float S[8], v[8], m = 0.f;
#pragma unroll
            for (int j = 0; j < 8; ++j) S[j] = 0.f;
            for (int k = 0; k < 2; ++k) { const int cc = dir ? (65 - k) : (64 + k); unpack8(ld16(base + (size_t)cc * 32768), v);
                const float M = scp[cc * 2], be = scp[cc * 2 + 1], mn = fmaxf(be + m, M), cS = expf(be + m - mn), cK = expf(M - mn);
#pragma unroll
                for (int j = 0; j < 8; ++j) S[j] = cS * S[j] + cK * v[j];
                m = mn; }
#pragma unroll 1
            for (int kb = 0; kb < 64; kb += 8) { u32x4 raw[8];
#pragma unroll
                for (int kk = 0; kk < 8; ++kk) { const int c = dir ? (63 - kb - kk) : (kb + kk); raw[kk] = ld16(base + (size_t)c * 32768); }
#pragma unroll
                for (int kk = 0; kk < 8; ++kk) { const int c = dir ? (63 - kb - kk) : (kb + kk); unpack8(raw[kk], v); *(u32x4*)(base + (size_t)c * 32768) = pack8(S);
                    if (e == 0 && dc == 0) MPREV[(dir * 16 + bh) * 64 + c] = m;
                    const float M = scp[c * 2], be = scp[c * 2 + 1], mn = fmaxf(be + m, M), cS = __expf(be + m - mn), cK = __expf(M - mn);
#pragma unroll
                    for (int j = 0; j < 8; ++j) S[j] = cS * S[j] + cK * v[j];
                    m = mn; } }
        }
        for (int task = gt; task < 4096; task += NGT) {
            const int d = task & 127, bh = (task >> 7) & 15, dir = task >> 11;
            const float* nl = NLOC + (size_t)((dir * 16 + bh) * 66) * 128 + d; float* np = NPREV + (size_t)((dir * 16 + bh) * 64) * 128 + d;
            const float* scp = MSCAL + (size_t)((dir * 16 + bh) * 66) * 2;
            float S = 0.f, m = 0.f;
            for (int k = 0; k < 2; ++k) { const int cc = dir ? (65 - k) : (64 + k);
                const float M = scp[cc * 2], be = scp[cc * 2 + 1], mn = fmaxf(be + m, M); S = expf(be + m - mn) * S + expf(M - mn) * nl[cc * 128]; m = mn; }
            for (int k = 0; k < 64; ++k) { const int c = dir ? (63 - k) : k; np[c * 128] = S;
                const float M = scp[c * 2], be = scp[c * 2 + 1], mn = fmaxf(be + m, M); S = expf(be + m - mn) * S + expf(M - mn) * nl[c * 128]; m = mn; }
        }
    }
    }
    SEAM(4);

    for (int rep_ = 0; rep_ < NREP(5); ++rep_) { if (rep_) xcd_barrier(bar);
    if (IN(5)) {
        bf16_t* YRG = (bf16_t*)(ws + WS_YRG); bf16_t* YMG = (bf16_t*)(ws + WS_YMG);
        for (int u = bx; u < 1024 + 2048; u += G) {
            int tid = threadIdx.x; asm volatile("" : "+v"(tid)); const int lane = tid & 63;
            const int r = lane & 15, q = lane >> 4;
            if (u < 1024) {
                const int bh = u >> 6, c = u & 63, b = bh >> 2, h = bh & 3, t0 = c * 128;
                const bf16_t* Pb = P + (size_t)(b * SEQ) * LDP;
                LAS unsigned char* Qs = lds;
                LAS unsigned char* Ks = lds + 34816;
                LAS unsigned char* ATT = lds + 73984;
                LAS unsigned char* R3 = lds + 108800;
                LAS float* ARR = (LAS float*)(lds + 143616);
                LAS float *ERF = ARR, *ECF = ARR + 128, *INF = ARR + 256, *EMF = ARR + 384, *ERB = ARR + 512, *ECB = ARR + 640, *INB = ARR + 768, *EMB = ARR + 896, *CF = ARR + 1024, *CB = ARR + 1152;
                if (wave < 2) {
                    const int dir = wave;
                    const float bi = mgb[dir * 8 + h], bfv = mgb[dir * 8 + 4 + h], mprev = MPREV[(dir * 16 + bh) * 64 + c];
                    const bf16_t* gp = Pb + (size_t)t0 * LDP + C_MG + dir * 8 + h;
                    const float i_lo = bf2f(gp[(size_t)lane * LDP]) + bi, i_hi = bf2f(gp[(size_t)(lane + 64) * LDP]) + bi;
                    const float f_lo = logsigf_(bf2f(gp[(size_t)lane * LDP + 4]) + bfv), f_hi = logsigf_(bf2f(gp[(size_t)(lane + 64) * LDP + 4]) + bfv);
                    float c_lo = f_lo, c_hi = f_hi;
                    if (dir == 0) scan128_sum_prefix(c_lo, c_hi, lane); else scan128_sum_suffix(c_lo, c_hi, lane);
                    const float ec_lo = i_lo - c_lo, ec_hi = i_hi - c_hi;
                    float g_lo = ec_lo, g_hi = ec_hi;
                    if (dir == 0) scan128_max_prefix(g_lo, g_hi, lane); else scan128_max_suffix(g_lo, g_hi, lane);
                    const float mt_lo = c_lo + fmaxf(mprev, g_lo), mt_hi = c_hi + fmaxf(mprev, g_hi);
                    LAS float* ER = dir ? ERB : ERF; LAS float* EC = dir ? ECB : ECF; LAS float* INr = dir ? INB : INF; LAS float* EM = dir ? EMB : EMF;
                    ER[lane] = c_lo - mt_lo; ER[lane + 64] = c_hi - mt_hi; EC[lane] = ec_lo; EC[lane + 64] = ec_hi;
                    INr[lane] = __expf(c_lo + mprev - mt_lo); INr[lane + 64] = __expf(c_hi + mprev - mt_hi); EM[lane] = __expf(-mt_lo); EM[lane + 64] = __expf(-mt_hi);
                }
                {   const int ch = (tid >> 5) * 8, s0 = tid & 31; float w0[8], w1[8], w2[8], o[8]; u32x4 rows[4][3];
                    const float* wq = mconv + h * 128 + ch; ldw8(wq, w0); ldw8(wq + 1024, w1); ldw8(wq + 2048, w2);
                    conv_rows(Pb + C_MQ + h * 128 + ch, t0, s0, SEQ, rows);
#pragma unroll
                    for (int i = 0; i < 4; ++i) { conv8r(rows[i][0], rows[i][1], rows[i][2], w0, w1, w2, o); *(LAS u32x4*)(Qs + (s0 + 32 * i) * 272 + ch * 2) = pack8(o); }
                    const float* wk = mconv + 512 + h * 128 + ch; ldw8(wk, w0); ldw8(wk + 1024, w1); ldw8(wk + 2048, w2);
                    conv_rows(Pb + C_MK + h * 128 + ch, t0, s0, SEQ, rows);
#pragma unroll
                    for (int i = 0; i < 4; ++i) { conv8r(rows[i][0], rows[i][1], rows[i][2], w0, w1, w2, o);
#pragma unroll
                        for (int j = 0; j < 8; ++j) o[j] *= 0.08838834764831845f;
                        *(LAS u32x4*)(Ks + (s0 + 32 * i) * 272 + ch * 2) = pack8(o); } }
                if (tid < 256) { const int rowi = tid >> 4, dch = (tid & 15) * 8; float o[8];
#pragma unroll
                    for (int j = 0; j < 8; ++j) o[j] = (rowi < 2) ? NPREV[(size_t)((rowi * 16 + bh) * 64 + c) * 128 + dch + j] : 0.f;
                    *(LAS u32x4*)(Ks + (128 + rowi) * 272 + dch * 2) = pack8(o); }
                { u32x4 raw_[4];
#pragma unroll
                for (int i = 0; i < 4; ++i) { const int task = tid + NTHR * i, s = task & 127, e8 = (task >> 7) * 8; raw_[i] = ld16(Pb + (size_t)(t0 + s) * LDP + C_MV + h * 256 + e8); }
#pragma unroll
                for (int i = 0; i < 4; ++i) { const int task = tid + NTHR * i, s = task & 127, e8 = (task >> 7) * 8; const u32x4 v = raw_[i];
#pragma unroll
                    for (int j = 0; j < 4; ++j) { *(LAS bf16_t*)(R3 + ((e8 + 2 * j) * 136 + s) * 2) = (bf16_t)(v[j] & 0xffffu); *(LAS bf16_t*)(R3 + ((e8 + 2 * j + 1) * 136 + s) * 2) = (bf16_t)(v[j] >> 16); } } }
                __syncthreads();
                {   f32x4 qk[1][9];
#pragma unroll
                    for (int n = 0; n < 9; ++n) qk[0][n] = (f32x4){0.f, 0.f, 0.f, 0.f};
                    wave_mma<1, 9>(qk, Qs + (16 * wave) * 272, 272, Ks, 272, 128, lane);
#pragma unroll
                    for (int j = 0; j < 4; ++j) { const int p = 16 * wave + q * 4 + j;
                        const float erf_ = ERF[p], erb_ = ERB[p];
                        float af[8], ab[8], rsf = 0.f, rsb = 0.f;
#pragma unroll
                        for (int nb = 0; nb < 8; ++nb) { const int s = nb * 16 + r; const float xv = qk[0][nb][j];
                            af[nb] = (s <= p) ? xv * __expf(erf_ + ECF[s]) : 0.f; ab[nb] = (s >= p) ? xv * __expf(erb_ + ECB[s]) : 0.f; rsf += af[nb]; rsb += ab[nb]; }
                        rsf = row16_sum(rsf); rsb = row16_sum(rsb);
                        const float qnf = __shfl(qk[0][8][j], q * 16), qnb = __shfl(qk[0][8][j], q * 16 + 1);
                        const float inf_ = INF[p], inb_ = INB[p];
                        const float dnf = fmaxf(fabsf(rsf + inf_ * qnf), EMF[p]), dnb = fmaxf(fabsf(rsb + inb_ * qnb), EMB[p]);
                        const float rf = 1.f / dnf, rb = 1.f / dnb;
#pragma unroll
                        for (int nb = 0; nb < 8; ++nb) *(LAS bf16_t*)(ATT + (p * 136 + nb * 16 + r) * 2) = f2bf(af[nb] * rf + ab[nb] * rb);
                        if (r == 0) { CF[p] = inf_ * rf; CB[p] = inb_ * rb; }
                        __builtin_amdgcn_sched_barrier(0); }
                }
                __syncthreads();
                f32x4 y[2][1][8];
#pragma unroll
                for (int a = 0; a < 2; ++a)
#pragma unroll
                    for (int n = 0; n < 8; ++n) y[a][0][n] = (f32x4){0.f, 0.f, 0.f, 0.f};
                wave_mma<1, 8>(y[0], ATT + (16 * wave) * 272, 272, R3, 272, 128, lane);
                __syncthreads();
                { u32x4 raw_[4];
#pragma unroll
                for (int i = 0; i < 4; ++i) { const int task = tid + NTHR * i, s = task & 127, e8 = (task >> 7) * 8; raw_[i] = ld16(Pb + (size_t)(t0 + s) * LDP + C_MV + h * 256 + 128 + e8); }
#pragma unroll
                for (int i = 0; i < 4; ++i) { const int task = tid + NTHR * i, s = task & 127, e8 = (task >> 7) * 8; const u32x4 v = raw_[i];
#pragma unroll
                    for (int j = 0; j < 4; ++j) { *(LAS bf16_t*)(R3 + ((e8 + 2 * j) * 136 + s) * 2) = (bf16_t)(v[j] & 0xffffu); *(LAS bf16_t*)(R3 + ((e8 + 2 * j + 1) * 136 + s) * 2) = (bf16_t)(v[j] >> 16); } } }
                __syncthreads();
                wave_mma<1, 8>(y[1], ATT + (16 * wave) * 272, 272, R3, 272, 128, lane);
#pragma unroll 1
                for (int dir = 0; dir < 2; ++dir) {
                    __syncthreads();
                    {   LAS float* CX = dir ? CB : CF;
#pragma unroll 1
                        for (int i = 0; i < 4; ++i) { const int task = tid + NTHR * i, s = task >> 4, ch = (task & 15) * 8; float o[8];
                            unpack8(*(const LAS u32x4*)(Qs + s * 272 + ch * 2), o); const float cx = CX[s];
#pragma unroll
                            for (int j = 0; j < 8; ++j) o[j] *= cx;
                            *(LAS u32x4*)(Ks + s * 272 + ch * 2) = pack8(o); } }
#pragma unroll 1
                    for (int half = 0; half < 2; ++half) {
                        if (half) __syncthreads();
                        { u32x4 raw_[4];
#pragma unroll
                        for (int i = 0; i < 4; ++i) { const int task = tid + NTHR * i, e = task >> 4, dch = (task & 15) * 8; raw_[i] = ld16(MST + ((size_t)((dir * 16 + bh) * 66 + c) * 256 + half * 128 + e) * 128 + dch); }
#pragma unroll
                        for (int i = 0; i < 4; ++i) { const int task = tid + NTHR * i, e = task >> 4, dch = (task & 15) * 8; *(LAS u32x4*)(R3 + e * 272 + dch * 2) = raw_[i]; } }
                        __syncthreads();
                        if (half == 0) wave_mma<1, 8>(y[0], Ks + (16 * wave) * 272, 272, R3, 272, 128, lane);
                        else wave_mma<1, 8>(y[1], Ks + (16 * wave) * 272, 272, R3, 272, 128, lane);
                    }
                }
                __syncthreads();
#pragma unroll
                for (int j = 0; j < 4; ++j) { const int p = 16 * wave + q * 4 + j;
                    float s1 = 0.f;
#pragma unroll
                    for (int nb = 0; nb < 8; ++nb) s1 += y[0][0][nb][j] + y[1][0][nb][j];
                    const float mean = row16_sum(s1) * (1.f / 256.f);
                    float s2 = 0.f;
#pragma unroll
                    for (int nb = 0; nb < 8; ++nb) { const float a = y[0][0][nb][j] - mean, bb = y[1][0][nb][j] - mean; s2 += a * a + bb * bb; }
                    const float rstd = rsqrtf(row16_sum(s2) * (1.f / 256.f) + 1e-6f);
#pragma unroll
                    for (int half = 0; half < 2; ++half)
#pragma unroll
                        for (int nb = 0; nb < 8; ++nb) { const int e = half * 128 + nb * 16 + r;
                            *(LAS bf16_t*)(Qs + (p * 264 + e) * 2) = f2bf((y[half][0][nb][j] - mean) * rstd); } }
                __syncthreads();
                {   u32x4 gr_[8];
#pragma unroll
                    for (int i = 0; i < 8; ++i) { const int task = tid + NTHR * i, p = task >> 5, e8 = (task & 31) * 8; gr_[i] = ld16(P + (size_t)(b * SEQ + t0 + p) * LDP + C_MO + h * 256 + e8); }
#pragma unroll
                    for (int i = 0; i < 8; ++i) { const int task = tid + NTHR * i, p = task >> 5, e8 = (task & 31) * 8; float yv[8], gv[8];
                        unpack8(*(const LAS u32x4*)(Qs + (p * 264 + e8) * 2), yv); unpack8(gr_[i], gv);
#pragma unroll
                        for (int jj = 0; jj < 8; ++jj) yv[jj] *= sigmoidf_(gv[jj]);
                        *(u32x4*)(YMG + (size_t)(b * SEQ + t0 + p) * 1024 + h * 256 + e8) = pack8(yv); } }
                __syncthreads();
            } else {
                const int v = u - 1024; const int bh = v >> 6, c = v & 63, b = bh >> 3, h = bh & 7, t0 = c * 128;
                const bf16_t* Pb = P + (size_t)(b * SEQ) * LDP;
                LAS unsigned char* Qs = lds;
                LAS unsigned char* Ks = lds + 18432;
                LAS unsigned char* AP = lds;
                LAS unsigned char* ATT = lds + 36864;
                LAS unsigned char* VT = lds + 71680;
                LAS unsigned char* ST = lds + 106496;
                const float lgf = logsigf_(rdec[h]), lgb = logsigf_(rdec[8 + h]);
                {   const int s = tid >> 2, ic = (tid & 3) * 8; float a1[8], a2[8], k1[8], k2[8], o1[8], o2[8];
                    const bf16_t* qp = Pb + (size_t)(t0 + s) * LDP + C_RQ + h * 64 + ic; unpack8(ld16(qp), a1); unpack8(ld16(qp + 32), a2);
                    const bf16_t* kp = Pb + (size_t)(t0 + s) * LDP + C_RK + h * 64 + ic; unpack8(ld16(kp), k1); unpack8(ld16(kp + 32), k2);
                    float cs[8], sn[8]; ldw8(ROTC + (t0 + s) * 32 + ic, cs); ldw8(ROTS + (t0 + s) * 32 + ic, sn);
#pragma unroll
                    for (int j = 0; j < 8; ++j) { o1[j] = a1[j] * cs[j] - a2[j] * sn[j]; o2[j] = a2[j] * cs[j] + a1[j] * sn[j]; }
                    *(LAS u32x4*)(Qs + s * 144 + ic * 2) = pack8(o1); *(LAS u32x4*)(Qs + s * 144 + (32 + ic) * 2) = pack8(o2);
#pragma unroll
                    for (int j = 0; j < 8; ++j) { o1[j] = (k1[j] * cs[j] - k2[j] * sn[j]) * 0.125f; o2[j] = (k2[j] * cs[j] + k1[j] * sn[j]) * 0.125f; }
                    *(LAS u32x4*)(Ks + s * 144 + ic * 2) = pack8(o1); *(LAS u32x4*)(Ks + s * 144 + (32 + ic) * 2) = pack8(o2); }
                { u32x4 raw_[4];
#pragma unroll
                for (int i = 0; i < 4; ++i) { const int task = tid + NTHR * i, s = task & 127, e8 = (task >> 7) * 8; raw_[i] = ld16(Pb + (size_t)(t0 + s) * LDP + C_RV + h * 128 + e8); }
#pragma unroll
                for (int i = 0; i < 4; ++i) { const int task = tid + NTHR * i, s = task & 127, e8 = (task >> 7) * 8; const u32x4 vv = raw_[i];
#pragma unroll
                    for (int j = 0; j < 4; ++j) { *(LAS bf16_t*)(VT + ((e8 + 2 * j) * 136 + s) * 2) = (bf16_t)(vv[j] & 0xffffu); *(LAS bf16_t*)(VT + ((e8 + 2 * j + 1) * 136 + s) * 2) = (bf16_t)(vv[j] >> 16); } } }
                { u32x4 raw_[4];
#pragma unroll
                for (int i = 0; i < 4; ++i) { const int task = tid + NTHR * i, e = task >> 4, dd = task & 15, dir = dd >> 3, dch = (dd & 7) * 8; raw_[i] = ld16(RST + ((size_t)((dir * 32 + bh) * 66 + c) * 128 + e) * 64 + dch); }
#pragma unroll
                for (int i = 0; i < 4; ++i) { const int task = tid + NTHR * i, e = task >> 4, dd = task & 15, dir = dd >> 3, dch = (dd & 7) * 8; *(LAS u32x4*)(ST + e * 272 + (dir * 64 + dch) * 2) = raw_[i]; } }
                __syncthreads();
                {   f32x4 qk[1][8];
#pragma unroll
                    for (int n = 0; n < 8; ++n) qk[0][n] = (f32x4){0.f, 0.f, 0.f, 0.f};
                    wave_mma<1, 8>(qk, Qs + (16 * wave) * 144, 144, Ks, 144, 64, lane);
#pragma unroll
                    for (int j = 0; j < 4; ++j) { const int p = 16 * wave + q * 4 + j;
#pragma unroll
                        for (int nb = 0; nb < 8; ++nb) { const int s = nb * 16 + r, dl = p - s;
                            const float D = (dl > 0) ? __expf(lgf * (float)dl) : ((dl < 0) ? __expf(lgb * (float)(-dl)) : 2.f);
                            *(LAS bf16_t*)(ATT + (p * 136 + s) * 2) = f2bf(qk[0][nb][j] * D); } }
                }
                float qa[16];
                const int pa = tid >> 2, da = (tid & 3) * 16;
                {   float t8[8]; unpack8(*(const LAS u32x4*)(Qs + pa * 144 + da * 2), t8);
#pragma unroll
                    for (int j = 0; j < 8; ++j) qa[j] = t8[j];
                    unpack8(*(const LAS u32x4*)(Qs + pa * 144 + (da + 8) * 2), t8);
#pragma unroll
                    for (int j = 0; j < 8; ++j) qa[8 + j] = t8[j]; }
                __syncthreads();
                {   const float df = __expf(lgf * (float)(pa + 1)), db = __expf(lgb * (float)(128 - pa)); float o[8];
#pragma unroll
                    for (int hh = 0; hh < 2; ++hh) {
#pragma unroll
                        for (int j = 0; j < 8; ++j) o[j] = qa[hh * 8 + j] * df;
                        *(LAS u32x4*)(AP + pa * 272 + (da + hh * 8) * 2) = pack8(o);
#pragma unroll
                        for (int j = 0; j < 8; ++j) o[j] = qa[hh * 8 + j] * db;
                        *(LAS u32x4*)(AP + pa * 272 + (64 + da + hh * 8) * 2) = pack8(o); } }
                __syncthreads();
                f32x4 y[1][8];
#pragma unroll
                for (int n = 0; n < 8; ++n) y[0][n] = (f32x4){0.f, 0.f, 0.f, 0.f};
                wave_mma<1, 8>(y, ATT + (16 * wave) * 272, 272, VT, 272, 128, lane);
                wave_mma<1, 8>(y, AP + (16 * wave) * 272, 272, ST, 272, 128, lane);
#pragma unroll
                for (int j = 0; j < 4; ++j) { const int p = 16 * wave + q * 4 + j; const int t = b * SEQ + t0 + p;
                    float s1 = 0.f;
#pragma unroll
                    for (int nb = 0; nb < 8; ++nb) s1 += y[0][nb][j];
                    const float mean = row16_sum(s1) * (1.f / 128.f);
                    float s2 = 0.f;
#pragma unroll
                    for (int nb = 0; nb < 8; ++nb) { const float a = y[0][nb][j] - mean; s2 += a * a; }
                    const float rstd = rsqrtf(row16_sum(s2) * (1.f / 128.f) + 1e-6f);
#pragma unroll
                    for (int nb = 0; nb < 8; ++nb) { const int e = nb * 16 + r; *(LAS bf16_t*)(ATT + (p * 136 + e) * 2) = f2bf((y[0][nb][j] - mean) * rstd); } }
                __syncthreads();
                {   u32x4 gr_[4];
#pragma unroll
                    for (int i = 0; i < 4; ++i) { const int task = tid + NTHR * i, p = task >> 4, e8 = (task & 15) * 8; gr_[i] = ld16(P + (size_t)(b * SEQ + t0 + p) * LDP + C_RG + h * 128 + e8); }
#pragma unroll
                    for (int i = 0; i < 4; ++i) { const int task = tid + NTHR * i, p = task >> 4, e8 = (task & 15) * 8; float yv[8], gv[8];
                        unpack8(*(const LAS u32x4*)(ATT + (p * 136 + e8) * 2), yv); unpack8(gr_[i], gv);
#pragma unroll
                        for (int jj = 0; jj < 8; ++jj) yv[jj] *= gv[jj] * sigmoidf_(gv[jj]);
                        *(u32x4*)(YRG + (size_t)(b * SEQ + t0 + p) * 1024 + h * 128 + e8) = pack8(yv); } }
                __syncthreads();
            }
        }
    }
    }
    SEAM(5);

    for (int rep_ = 0; rep_ < NREP(6); ++rep_) { if (rep_) xcd_barrier(bar);
    if (IN(6)) {
        pg8::StaticOrder S; S.init(NTOK, DM, G, bx);
        { pg8::Gemm g{(const bf16_t*)(ws + WS_YRG), (const bf16_t*)(ws + WS_WRO), 1024, 1024}; pg8::EpiU<0> E{P, (bf16_t*)(ws + WS_U), C_GR}; pg8::gemm_phase<pg8::EpiU<0>, pg8::StaticOrder>(lds, g, S, E); }
        { pg8::Gemm g{(const bf16_t*)(ws + WS_YMG), (const bf16_t*)(ws + WS_WMO), 1024, 1024}; pg8::EpiU<1> E{P, (bf16_t*)(ws + WS_U), C_GM}; pg8::gemm_phase<pg8::EpiU<1>, pg8::StaticOrder>(lds, g, S, E); }
    }
    }
    SEAM(6);

    for (int rep_ = 0; rep_ < NREP(7); ++rep_) { if (rep_) xcd_barrier(bar);
    if (IN(7)) {
        pg8::StaticOrder S; S.init(NTOK, DM, G, bx);
        pg8::Gemm g{(const bf16_t*)(ws + WS_U), (const bf16_t*)(ws + WS_WO), DM, DM}; pg8::EpiX1 E{args.in[IN_X], MOD, args.out, (float*)(ws + WS_ROWSQ)};
        pg8::gemm_phase<pg8::EpiX1, pg8::StaticOrder>(lds, g, S, E);
    }
    }
    SEAM(7);

    for (int rep_ = 0; rep_ < NREP(8); ++rep_) { if (rep_) xcd_barrier(bar);
    if (IN(8)) {
        const float* g2 = args.in[IN_N2G]; const float* rowsq = (const float*)(ws + WS_ROWSQ); bf16_t* H2 = (bf16_t*)(ws + WS_H2); const float* x1 = args.out;
        for (int row = gw; row < NTOK; row += NGW) {
            const int b = row >> 13;
            float ss = (lane < 32) ? rowsq[(size_t)lane * NTOK + row] : 0.f;
            const float rstd = rsqrtf(wave_sum(ss) * (1.f / DM) + 1e-6f);
            const float* shp = MOD + b * 12288 + 3 * DM; const float* scp = shp + DM;
#pragma unroll
            for (int j = 0; j < 8; ++j) { const int idx = 4 * (lane + 64 * j); const f32x4 v = *(const f32x4*)(x1 + (size_t)row * DM + idx);
                const f32x4 g = *(const f32x4*)(g2 + idx), sh = *(const f32x4*)(shp + idx), sc = *(const f32x4*)(scp + idx);
                const f32x4 hv = v * rstd * g * (sc + 1.f) + sh; u32x2 o; o.x = pk2(hv[0], hv[1]); o.y = pk2(hv[2], hv[3]); *(u32x2*)(H2 + (size_t)row * DM + idx) = o; }
        }
        { u32x4* ix = (u32x4*)(ws + WS_IDX); const u32x4 inv = {0xFFF0FFF0u, 0xFFF0FFF0u, 0xFFF0FFF0u, 0xFFF0FFF0u};
          for (int i = gt; i < 64 * 16 * 512 * 16 * 2 / 16; i += NGT) ix[i] = inv; }
        const float* pd = args.in[IN_PD]; const float* pu = args.in[IN_PU]; bf16_t* d16 = (bf16_t*)(ws + WS_DN16); _Float16* u16 = (_Float16*)(ws + WS_UP16);
        for (int i = gt; i < 2 * (16384 * DM / 8); i += NGT) { const int which = i >= (16384 * DM / 8); const size_t k = (size_t)(which ? i - 16384 * DM / 8 : i) * 8;
            const float* s = (which ? pu : pd) + k; const f32x4 a = *(const f32x4*)s, b2 = *(const f32x4*)(s + 4);
            if (which) { half8_t o; o[0] = (_Float16)a[0]; o[1] = (_Float16)a[1]; o[2] = (_Float16)a[2]; o[3] = (_Float16)a[3]; o[4] = (_Float16)b2[0]; o[5] = (_Float16)b2[1]; o[6] = (_Float16)b2[2]; o[7] = (_Float16)b2[3]; *(half8_t*)(u16 + k) = o; }
            else { u32x4 o; o.x = pk2(a[0], a[1]); o.y = pk2(a[2], a[3]); o.z = pk2(b2[0], b2[1]); o.w = pk2(b2[2], b2[3]); *(u32x4*)(d16 + k) = o; } }
    }
    }
    SEAM(8);

    for (int rep_ = 0; rep_ < NREP(9); ++rep_) { if (rep_) xcd_barrier(bar);
    if (IN(9)) {
        pg8::StaticOrder S; S.init(NTOK, DM, G, bx);
        pg8::Gemm g{(const bf16_t*)(ws + WS_H2), (const bf16_t*)(ws + WS_WQ), DM, DM}; pg8::EpiQ E{(bf16_t*)(ws + WS_Q)};
        pg8::gemm_phase<pg8::EpiQ, pg8::StaticOrder>(lds, g, S, E);
    }
    }
    SEAM(9);

    for (int rep_ = 0; rep_ < NREP(10); ++rep_) { if (rep_) xcd_barrier(bar);
    if (IN(10)) {
        const bf16_t* Qb = (const bf16_t*)(ws + WS_Q); const bf16_t* K16 = (const bf16_t*)(ws + WS_KEYS); int* EID = (int*)(ws + WS_EID); float* GW = (float*)(ws + WS_GW);
        LAS unsigned char* QT = lds;
        LAS unsigned char* KY = lds + 67584;
        LAS unsigned* LST = (LAS unsigned*)(lds + 137216);
        int hprev = -1;
        u32x4 qn[8];
        if (bx < 2048) {
#pragma unroll
            for (int i = 0; i < 8; ++i) { const int task = tid + NTHR * i, tok = task >> 5, c8 = (task & 31) * 8; qn[i] = ld16(Qb + (size_t)((bx >> 3) * 128 + tok) * DM + (bx & 7) * 256 + c8); } }
        for (int u = bx; u < 2048; u += G) {
            const int tb = u >> 3, h = u & 7;
#pragma unroll
            for (int i = 0; i < 8; ++i) { const int task = tid + NTHR * i, tok = task >> 5, c8 = (task & 31) * 8; *(LAS u32x4*)(QT + tok * 528 + c8 * 2) = qn[i]; }
            if (h != hprev) { u32x4 raw_[8]; hprev = h;
#pragma unroll
            for (int i = 0; i < 8; ++i) { const int task = tid + NTHR * i, row = task >> 4, c8 = (task & 15) * 8; raw_[i] = ld16(K16 + ((size_t)h * 256 + row) * 128 + c8); }
#pragma unroll
            for (int i = 0; i < 8; ++i) { const int task = tid + NTHR * i, row = task >> 4, c8 = (task & 15) * 8; *(LAS u32x4*)(KY + row * 272 + c8 * 2) = raw_[i]; } }
            __syncthreads();
            if (u + G < 2048) { const int un = u + G;
#pragma unroll
                for (int i = 0; i < 8; ++i) { const int task = tid + NTHR * i, tok = task >> 5, c8 = (task & 31) * 8; qn[i] = ld16(Qb + (size_t)((un >> 3) * 128 + tok) * DM + (un & 7) * 256 + c8); } }
            const int r = lane & 15, q = lane >> 4;
            float L0[16], L1[16];
#pragma unroll
            for (int pp = 0; pp < 2; ++pp) {
                f32x4 sc[8][1];
#pragma unroll
                for (int mb = 0; mb < 8; ++mb) sc[mb][0] = (f32x4){0.f, 0.f, 0.f, 0.f};
                wave_mma<8, 1>(sc, KY + (pp * 128) * 272, 272, QT + (16 * wave) * 528 + pp * 256, 528, 128, lane);
                float L[16];
#pragma unroll
                for (int i = 0; i < 16; ++i) L[i] = -__builtin_inff();
#pragma unroll
                for (int mb = 0; mb < 8; ++mb)
#pragma unroll
                    for (int j = 0; j < 4; ++j) { const unsigned key = (unsigned)(mb * 16 + q * 4 + j);
                        ins16(L, __uint_as_float((__float_as_uint(sc[mb][0][j]) & ~127u) | key)); }
#pragma unroll
                for (int sh = 16; sh <= 32; sh <<= 1) { float o[16];
#pragma unroll
                    for (int i = 0; i < 16; ++i) o[i] = __shfl_xor(L[i], sh);
#pragma unroll
                    for (int i = 0; i < 16; ++i) ins16(L, o[i]); }
#pragma unroll
                for (int i = 0; i < 16; ++i) { if (pp == 0) L0[i] = L[i]; else L1[i] = L[i]; }
            }
            if (q == 0) {
#pragma unroll
                for (int i = 0; i < 16; ++i) { LST[(16 * wave + r) * 32 + i] = __float_as_uint(L0[i]); LST[(16 * wave + r) * 32 + 16 + i] = __float_as_uint(L1[i]); } }
            float T[16];
#pragma unroll
            for (int i = 0; i < 16; ++i) T[i] = -__builtin_inff();
#pragma unroll
            for (int a = 0; a < 16; ++a)
#pragma unroll
                for (int b2 = 0; b2 < 16; ++b2) if ((a + 1) * (b2 + 1) <= 16) { const float cnd = L0[a] + L1[b2]; ins16(T, __uint_as_float((__float_as_uint(cnd) & ~255u) | (unsigned)(a * 16 + b2))); }
            __syncthreads();
            float den = 0.f, ev[16];
#pragma unroll
            for (int i = 0; i < 16; ++i) { ev[i] = __expf(T[i] - T[0]); den += ev[i]; }
            const float rden = 1.f / den;
            const int tok = 16 * wave + r; const size_t ob = (size_t)(tb * 128 + tok) * 128 + h * 16 + q * 4;
#pragma unroll
            for (int kk = 0; kk < 4; ++kk) {
                const float tv = (q == 0) ? T[kk] : (q == 1 ? T[4 + kk] : (q == 2 ? T[8 + kk] : T[12 + kk]));
                const float gv = (q == 0) ? ev[kk] : (q == 1 ? ev[4 + kk] : (q == 2 ? ev[8 + kk] : ev[12 + kk]));
                const unsigned code = __float_as_uint(tv) & 255u;
                const unsigned i1 = LST[tok * 32 + (code >> 4)] & 127u, i2 = LST[tok * 32 + 16 + (code & 15u)] & 127u;
                EID[ob + kk] = (int)(i1 * 128u + i2); GW[ob + kk] = gv * rden; }
            __syncthreads();
        }
    }
    }
    SEAM(10);

    for (int rep_ = 0; rep_ < NREP(11); ++rep_) { if (rep_) xcd_barrier(bar);
    if (IN(11)) {
        const int* EID = (const int*)(ws + WS_EID); const float* GW = (const float*)(ws + WS_GW);
        unsigned short* IDX = (unsigned short*)(ws + WS_IDX); float* GJ = (float*)(ws + WS_GJ);
        int* OVC = (int*)(ws + WS_OVC); unsigned* OVE = (unsigned*)(ws + WS_OVE);
        for (int cku = gw; cku < NTOK / 8; cku += NGW) {
            const int hh = lane & 7, t = cku * 8 + (lane >> 3), TBi = t >> 9, tl = t & 511;
            int eid[16]; float gg[16];
#pragma unroll
            for (int q4 = 0; q4 < 4; ++q4) { const u32x4 e4 = *(const u32x4*)(EID + (size_t)t * 128 + hh * 16 + 4 * q4); const f32x4 g4v = *(const f32x4*)(GW + (size_t)t * 128 + hh * 16 + 4 * q4);
#pragma unroll
                for (int i = 0; i < 4; ++i) { eid[4 * q4 + i] = (int)e4[i]; gg[4 * q4 + i] = g4v[i]; } }
            unsigned hc[4] = {0u, 0u, 0u, 0u};
#pragma unroll
            for (int k = 0; k < 16; ++k) { const unsigned eb = EBLK(eid[k]), inc = 1u << ((eb & 3u) * 8u), sel = eb >> 2;
#pragma unroll
                for (int w4 = 0; w4 < 4; ++w4) hc[w4] += (sel == (unsigned)w4) ? inc : 0u; }
            unsigned run[4];
#pragma unroll
            for (int w4 = 0; w4 < 4; ++w4) { unsigned v = hc[w4];
#pragma unroll
                for (int o = 1; o < 8; o <<= 1) { const unsigned uu = (unsigned)__shfl_up((int)v, o, 8); if (hh >= o) v += uu; }
                run[w4] = v - hc[w4]; }
            int ovown = 0;
#pragma unroll
            for (int e = 0; e < 16; ++e) { const int bs = (int)((run[e >> 2] >> ((e & 3) * 8)) & 255u), ow = (int)((hc[e >> 2] >> ((e & 3) * 8)) & 255u);
                const int lo = bs > LCAP ? bs : LCAP; ovown += (bs + ow > lo) ? (bs + ow - lo) : 0; }
            int ovinc = ovown;
#pragma unroll
            for (int o = 1; o < 8; o <<= 1) { const int uu = __shfl_up(ovinc, o, 8); if (hh >= o) ovinc += uu; }
            int ovpos = ovinc - ovown;
            if (hh == 7) OVC[t] = ovinc;
            if (hh == 7) { unsigned char* CNT = (unsigned char*)(ws + WS_NMAXG);
#pragma unroll
                for (int e = 0; e < 16; ++e) { const unsigned tot = ((run[e >> 2] + hc[e >> 2]) >> ((e & 3) * 8)) & 255u; CNT[(size_t)(TBi * 16 + e) * 512 + tl] = (unsigned char)(tot < (unsigned)LCAP ? tot : (unsigned)LCAP); } }
#pragma unroll
            for (int k = 0; k < 16; ++k) { const unsigned eb = EBLK(eid[k]), sh = (eb & 3u) * 8u, sel = eb >> 2;
                const unsigned cur = (sel == 0u) ? run[0] : (sel == 1u ? run[1] : (sel == 2u ? run[2] : run[3]));
                const unsigned j = (cur >> sh) & 255u;
#pragma unroll
                for (int w4 = 0; w4 < 4; ++w4) run[w4] += (sel == (unsigned)w4) ? (1u << sh) : 0u;
                if (j < (unsigned)LCAP) { const unsigned el = EROWIN(eid[k]);
                    IDX[((size_t)(TBi * 16 + eb) * 512 + tl) * 16 + j] = (unsigned short)(((el << 2) | (el & 3u)) << 4); GJ[((size_t)(TBi * 16 + eb) * LCAP + j) * 512 + tl] = gg[k]; }
                else { OVE[((size_t)t * 128 + ovpos) * 2] = (unsigned)eid[k]; OVE[((size_t)t * 128 + ovpos) * 2 + 1] = __float_as_uint(gg[k]); ++ovpos; }
            }
        }
    }
    }
    SEAM(11);

    for (int rep_ = 0; rep_ < NREP(12); ++rep_) { if (rep_) xcd_barrier(bar);
    if (IN(12)) {
        const bf16_t* H2 = (const bf16_t*)(ws + WS_H2); const bf16_t* d16 = (const bf16_t*)(ws + WS_DN16);
        const unsigned short* IDX = (const unsigned short*)(ws + WS_IDX); const float* GJ = (const float*)(ws + WS_GJ); unsigned* EW = (unsigned*)(ws + WS_EW);
        LAS unsigned char* IDL = lds + 131072;
        for (int u = bx; u < 512; u += G) {
            int tid = threadIdx.x; asm volatile("" : "+v"(tid)); const int lane = tid & 63;
            const int xx = u & 7, rest = u >> 3, wq = rest & 31, eb = wq & 15, TBi = 4 * xx + 2 * (rest >> 5) + (wq >> 4);
            const int c4 = lane & 3, g4 = lane >> 2;
            LAS unsigned short* PERMS = (LAS unsigned short*)(lds + 155648); LAS unsigned* HIST = (LAS unsigned*)(lds + 157696); LAS unsigned char* CNTL = lds + 157760;
            __syncthreads();
            if (tid < 16) HIST[tid] = 0u;
            unsigned cnt2[2];
#pragma unroll
            for (int k2 = 0; k2 < 2; ++k2) { const int i = tid + NTHR * k2; const size_t hb = (size_t)((TBi * 2 + (i >> 9)) * 16 + eb) * 512 + (i & 511);
                const u32x4 e0 = *(const u32x4*)(IDX + hb * 16); const u32x2 e1 = *(const u32x2*)(IDX + hb * 16 + 8);
                *(LAS u32x2*)(IDL + i * 24) = (u32x2){e0[0], e0[1]}; *(LAS u32x2*)(IDL + i * 24 + 8) = (u32x2){e0[2], e0[3]}; *(LAS u32x2*)(IDL + i * 24 + 16) = e1;
                cnt2[k2] = ((const unsigned char*)(ws + WS_NMAXG))[hb]; CNTL[i] = (unsigned char)cnt2[k2]; }
            __syncthreads();
            unsigned rank2[2];
#pragma unroll
            for (int k2 = 0; k2 < 2; ++k2) rank2[k2] = __hip_atomic_fetch_add(&HIST[cnt2[k2]], 1u, __ATOMIC_RELAXED, __HIP_MEMORY_SCOPE_WORKGROUP);
            __syncthreads();
#pragma unroll
            for (int k2 = 0; k2 < 2; ++k2) { unsigned base = 0u; for (unsigned c2 = cnt2[k2] + 1u; c2 <= (unsigned)LCAP; ++c2) base += HIST[c2]; PERMS[base + rank2[k2]] = (unsigned short)(tid + NTHR * k2); }
            __syncthreads();
            int tlg[8], nmx[8];
#pragma unroll
            for (int grp = 0; grp < 8; ++grp) { tlg[grp] = PERMS[wave * 128 + grp * 16 + g4]; nmx[grp] = __builtin_amdgcn_readfirstlane((int)CNTL[PERMS[wave * 128 + grp * 16]]); }
            float acc[8][LCAP];
#pragma unroll
            for (int grp = 0; grp < 8; ++grp)
#pragma unroll
                for (int j = 0; j < LCAP; ++j) acc[grp][j] = 0.f;
            const bf16_t* dsrc = d16;
            const bf16_t* hsrc = H2 + (size_t)(TBi * 1024) * DM + c4 * 8;
#define DN_DMA1(fbv, bufv, i2) do { const int Lb = (i2) * 8192 + wave * 1024 + lane * 16, r = Lb >> 6, cp = (Lb >> 4) & 3; \
                __builtin_amdgcn_global_load_lds((const unsigned*)(dsrc + (size_t)EROW(eb, r) * DM + (fbv) * 32 + ((cp ^ (r & 3)) * 8)), (LAS unsigned*)(lds + (bufv) * 65536 + (i2) * 8192 + wave * 1024), 16, 0, 0); } while (0)
            u32x4 hq[8];
#pragma unroll
            for (int i2 = 0; i2 < 8; ++i2) DN_DMA1(0, 0, i2);
#pragma unroll
            for (int grp = 0; grp < 8; ++grp) hq[grp] = ld16(hsrc + (size_t)tlg[grp] * DM);
            asm volatile("s_waitcnt vmcnt(0)" ::: "memory");
            __syncthreads();
            const u32x2 ea0 = *(const LAS u32x2*)(IDL + tlg[0] * 24), eb0 = *(const LAS u32x2*)(IDL + tlg[0] * 24 + 8), ec0 = *(const LAS u32x2*)(IDL + tlg[0] * 24 + 16);
            u32x2 ean = ea0, ebn = eb0, ecn = ec0;
#pragma unroll 1
            for (int fb = 0; fb < 64; ++fb) {
                const bool more = (fb + 1 < 64);
                const unsigned boff = (unsigned)(fb & 1) << 16, c4s = (unsigned)c4 << 4;
#pragma unroll
                for (int grp = 0; grp < 8; ++grp) {
                    const u32x2 ea = ean, ebb = ebn, ec = ecn;
                    if (grp + 1 < 8) { const LAS unsigned char* ipn = IDL + tlg[grp + 1] * 24; ean = *(const LAS u32x2*)ipn; ebn = *(const LAS u32x2*)(ipn + 8); ecn = *(const LAS u32x2*)(ipn + 16); }
                    else { ean = ea0; ebn = eb0; ecn = ec0; }
                    if (grp >= 3) { if (more) { if (grp == 3) asm volatile("s_waitcnt vmcnt(13)" ::: "memory"); else asm volatile("s_waitcnt vmcnt(15)" ::: "memory"); }
                                    else { if (grp == 3) asm volatile("s_waitcnt vmcnt(4)" ::: "memory"); else if (grp == 4) asm volatile("s_waitcnt vmcnt(3)" ::: "memory"); else if (grp == 5) asm volatile("s_waitcnt vmcnt(2)" ::: "memory");
                                           else if (grp == 6) asm volatile("s_waitcnt vmcnt(1)" ::: "memory"); else asm volatile("s_waitcnt vmcnt(0)" ::: "memory"); } }
#pragma unroll
                    for (int jb = 0; jb < LCAP; jb += 4) {
                        const int bt = grp * 3 + (jb >> 2);
                        if (more && (bt % 3 == 0) && bt < 12) {
#pragma unroll
                            for (int i2 = 0; i2 < 2; ++i2) DN_DMA1(fb + 1, (fb + 1) & 1, (bt / 3) * 2 + i2); }
                        if (jb < nmx[grp]) {
                        u32x4 v[4];
#pragma unroll
                        for (int jj = 0; jj < 4; ++jj) { const int j = jb + jj; const unsigned wd = (j < 4) ? ea[j >> 1] : (j < 8 ? ebb[(j - 4) >> 1] : ec[(j - 8) >> 1]); const unsigned ko = (j & 1) ? (wd >> 16) : (wd & 0xFFFFu);
                            v[jj] = *(const LAS u32x4*)(lds + ((ko ^ c4s) + boff)); }
#pragma unroll
                        for (int jj = 0; jj < 4; ++jj) { float a = acc[grp][jb + jj];
#pragma unroll
                            for (int q4 = 0; q4 < 4; ++q4) { const unsigned xa = v[jj][q4], xb = hq[grp][q4]; a = __builtin_amdgcn_fdot2_f32_bf16(__builtin_bit_cast(bf16x2_t, xa), __builtin_bit_cast(bf16x2_t, xb), a, false); }
                            acc[grp][jb + jj] = a; }
                        }
                        __builtin_amdgcn_sched_barrier(0);
                    }
                    if (more) { const bf16_t* hp = hsrc + (size_t)tlg[grp] * DM + (fb + 1) * 32; asm volatile("global_load_dwordx4 %0, %1, off" : "=v"(hq[grp]) : "v"(hp) : "memory"); }
                }
                asm volatile("s_waitcnt vmcnt(5)" ::: "memory");
                __builtin_amdgcn_s_barrier();
            }
#undef DN_DMA1
#pragma unroll
            for (int grp = 0; grp < 8; ++grp) {
                const int tl = tlg[grp]; const size_t hb = (size_t)((TBi * 2 + (tl >> 9)) * 16 + eb);
                const int cnt = (int)CNTL[tl];
                float sm[3], gj[3];
#pragma unroll
                for (int jq = 0; jq < 3; ++jq) {
#pragma unroll
                    for (int i = 0; i < 4; ++i) { float sacc = acc[grp][4 * jq + i]; sacc += __shfl_xor(sacc, 1); sacc += __shfl_xor(sacc, 2); if (i == 0) sm[jq] = sacc; else sm[jq] = (c4 == i) ? sacc : sm[jq]; } }
#pragma unroll
                for (int jq = 0; jq < 3; ++jq) { const int j = 4 * jq + c4; gj[jq] = (j < cnt) ? GJ[(hb * LCAP + j) * 512 + (tl & 511)] : 0.f; }
#pragma unroll
                for (int jq = 0; jq < 3; ++jq) { const int j = 4 * jq + c4; const unsigned ent = *(const LAS unsigned short*)(IDL + tl * 24 + j * 2);
                    unsigned o = 0u;
                    if (j < cnt) { const _Float16 wh = (_Float16)(gj[jq] * gelu_erf(sm[jq])); o = (ent & 0xFFC0u) | ((unsigned)__builtin_bit_cast(unsigned short, wh) << 16); }
                    EW[((size_t)(TBi * 16 + eb) * 1024 + tl) * LCAP + j] = o; }
            }
        }
    }
    }
    SEAM(12);

    for (int rep_ = 0; rep_ < NREP(13); ++rep_) { if (rep_) xcd_barrier(bar);
    if (IN(13)) {
        const _Float16* u16 = (const _Float16*)(ws + WS_UP16); const unsigned* EW = (const unsigned*)(ws + WS_EW);
        float* out = args.out;
        {
            const bf16_t* H2o = (const bf16_t*)(ws + WS_H2); const bf16_t* d16o = (const bf16_t*)(ws + WS_DN16);
            const int* OVC = (const int*)(ws + WS_OVC); unsigned* OVE = (unsigned*)(ws + WS_OVE);
            int novN = (gw < NTOK) ? OVC[gw] : 0; u32x4 oN = (gw < NTOK) ? *(const u32x4*)(OVE + (size_t)gw * 256) : (u32x4){0u, 0u, 0u, 0u};
            for (int t = gw; t < NTOK; t += NGW) {
                const int nov = __builtin_amdgcn_readfirstlane(novN); const u32x4 o01 = oN;
                if (t + NGW < NTOK) { novN = OVC[t + NGW]; oN = *(const u32x4*)(OVE + (size_t)(t + NGW) * 256); }
                if (nov > 0) {
                    u32x4 hx[4];
#pragma unroll
                    for (int j = 0; j < 4; ++j) hx[j] = ld16(H2o + (size_t)t * DM + 8 * (lane + 64 * j));
                    for (int k0 = 0; k0 < nov; k0 += 2) {
                        u32x4 dr[2][4]; float gk[2];
#pragma unroll
                        for (int kk = 0; kk < 2; ++kk) { const bool ok = (k0 + kk < nov); const int k = ok ? k0 + kk : k0;
                            const unsigned eu = (k0 == 0) ? ((kk == 1 && ok) ? o01.z : o01.x) : OVE[((size_t)t * 128 + k) * 2], gu = (k0 == 0) ? ((kk == 1 && ok) ? o01.w : o01.y) : OVE[((size_t)t * 128 + k) * 2 + 1];
                            const int e = __builtin_amdgcn_readfirstlane((int)eu); gk[kk] = __uint_as_float(gu);
#pragma unroll
                            for (int j = 0; j < 4; ++j) dr[kk][j] = ld16(d16o + (size_t)e * DM + 8 * (lane + 64 * j)); }
#pragma unroll
                        for (int kk = 0; kk < 2; ++kk) { float sdot = 0.f;
#pragma unroll
                            for (int j = 0; j < 4; ++j)
#pragma unroll
                                for (int q4 = 0; q4 < 4; ++q4) { const unsigned xa = dr[kk][j][q4], xb = hx[j][q4]; sdot = __builtin_amdgcn_fdot2_f32_bf16(__builtin_bit_cast(bf16x2_t, xa), __builtin_bit_cast(bf16x2_t, xb), sdot, false); }
                            sdot = wave_sum(sdot);
                            if (k0 + kk < nov && lane == 0) OVE[((size_t)t * 128 + k0 + kk) * 2 + 1] = pk2(0.f, gk[kk] * gelu_erf(sdot)) & 0xffff0000u; }
                    }
                }
            }
        }
        for (int u = bx; u < 2048; u += G) {
            int tid = threadIdx.x; asm volatile("" : "+v"(tid)); const int lane = tid & 63;
            const int xx = u & 7, rest = u >> 3, TBi = rest & 31, fb = xx + 8 * (rest >> 5);
            const int c4 = lane & 3, g4 = lane >> 2;
            float acc[8][8];
#pragma unroll
            for (int grp = 0; grp < 8; ++grp)
#pragma unroll
                for (int i = 0; i < 8; ++i) acc[grp][i] = 0.f;
            const _Float16* usrc = u16 + fb * 32;
            const unsigned* esrc = EW + ((size_t)(TBi * 16) * 1024 + wave * 128 + g4) * LCAP;
            const unsigned evo = (unsigned)(wave * 128 + g4) * (LCAP * 4u);
#define UP_DMA1(ebv, bufv, i2) do { const int Lb = (i2) * 8192 + wave * 1024 + lane * 16, r = Lb >> 6, cp = (Lb >> 4) & 3; \
                __builtin_amdgcn_global_load_lds((const unsigned*)(usrc + (size_t)EROW(ebv, r) * DM + (cp * 8)), (LAS unsigned*)(lds + (bufv) * 65536 + (i2) * 8192 + wave * 1024), 16, 0, 0); } while (0)
#define UP_DMA(ebv, bufv) do { _Pragma("unroll") for (int i2 = 0; i2 < 8; ++i2) { const int Lb = i2 * 8192 + wave * 1024 + lane * 16, r = Lb >> 6, cp = (Lb >> 4) & 3; \
                __builtin_amdgcn_global_load_lds((const unsigned*)(usrc + (size_t)EROW(ebv, r) * DM + (cp * 8)), (LAS unsigned*)(lds + (bufv) * 65536 + i2 * 8192 + wave * 1024), 16, 0, 0); } } while (0)
            u32x4 ew[8][3];
            __syncthreads();
            if (!VARON(13, VAR_NODMA)) UP_DMA(0, 0);
#pragma unroll
            for (int grp = 0; grp < 8; ++grp)
#pragma unroll
                for (int j = 0; j < 3; ++j) ew[grp][j] = *(const u32x4*)(esrc + (size_t)grp * 16 * LCAP + 4 * j);
            asm volatile("s_waitcnt vmcnt(0)" ::: "memory");
            __syncthreads();
#pragma unroll 1
            for (int eb = 0; eb < 16; ++eb) {
                const bool more = (eb + 1 < 16);
                const unsigned kb = (unsigned)(size_t)lds + ((unsigned)(eb & 1) << 16) + ((unsigned)c4 << 4);
#define UP_ADDR(e_) ({ unsigned a_; asm("v_add_u32_sdwa %0, %1, %2 dst_sel:DWORD dst_unused:UNUSED_PAD src0_sel:WORD_0 src1_sel:DWORD" : "=v"(a_) : "v"(e_), "v"(kb)); a_; })
                u32x4 vc[4], vn[4];
#pragma unroll
                for (int jj = 0; jj < 4; ++jj) vc[jj] = *(const LAS u32x4*)(size_t)UP_ADDR(ew[0][0][jj]);
                unsigned a16[4];
#pragma unroll
                for (int bt = 0; bt < 24; ++bt) {
                    const int grp = bt / 3, jb = (bt % 3) * 4;
                    if (jb == 0) {
#pragma unroll
                        for (int q4 = 0; q4 < 4; ++q4) a16[q4] = 0u; }
                    if (more && (bt % 4 == 0) && bt < 16) {
#pragma unroll
                        for (int i2 = 0; i2 < 2; ++i2) UP_DMA1(eb + 1, (eb + 1) & 1, (bt / 4) * 2 + i2); }
                    if (bt == 16) {
                        if (more) asm volatile("s_waitcnt vmcnt(23)" ::: "memory");
                        else asm volatile("s_waitcnt vmcnt(0)" ::: "memory"); }
                    if (bt + 1 < 24) { const int g2 = (bt + 1) / 3, j2 = ((bt + 1) % 3) * 4;
#pragma unroll
                        for (int jj = 0; jj < 4; ++jj) vn[jj] = *(const LAS u32x4*)(size_t)UP_ADDR(ew[g2][j2 >> 2][jj]); }
#pragma unroll
                    for (int jj = 0; jj < 4; ++jj) {
#pragma unroll
                        for (int q4 = 0; q4 < 4; ++q4) { const unsigned xv = vc[jj][q4]; asm("v_pk_fma_f16 %0, %1, %2, %0 op_sel:[0,1,0] op_sel_hi:[1,1,1]" : "+v"(a16[q4]) : "v"(xv), "v"(ew[grp][jb >> 2][jj])); } }
                    if (jb == 8) {
#pragma unroll
                        for (int q4 = 0; q4 < 4; ++q4) { const unsigned ab = a16[q4]; acc[grp][2 * q4] = fmix_lo(1.0f, ab, acc[grp][2 * q4]); acc[grp][2 * q4 + 1] = fmix_hi(1.0f, ab, acc[grp][2 * q4 + 1]); }
                        if (more) {
#pragma unroll
                            for (int j = 0; j < 3; ++j) { const unsigned* ep = EW + (size_t)(TBi * 16 + eb + 1) * 1024 * LCAP + (grp >> 2) * (64 * LCAP);
                                asm volatile("global_load_dwordx4 %0, %1, %2 offset:%3" : "=v"(ew[grp][j]) : "v"(evo), "s"(ep), "n"((grp & 3) * 16 * LCAP * 4 + j * 16) : "memory"); } } }
#pragma unroll
                    for (int jj = 0; jj < 4; ++jj) vc[jj] = vn[jj];
                }
                asm volatile("s_waitcnt vmcnt(6)" ::: "memory");
                __builtin_amdgcn_s_barrier();
            }
#undef UP_DMA
#undef UP_DMA1
#undef UP_ADDR
            {
                const int col = fb * 32 + c4 * 8; const int bb = (TBi * 1024) >> 13;
                const float* gp = MOD + bb * 12288 + 5 * DM + col; const f32x4 gv0 = *(const f32x4*)gp, gv1 = *(const f32x4*)(gp + 4);
                f32x4 xq[8][2];
#pragma unroll
                for (int grp = 0; grp < 8; ++grp) { const float* xp = out + (size_t)(TBi * 1024 + wave * 128 + grp * 16 + g4) * DM + col; xq[grp][0] = *(const f32x4*)xp; xq[grp][1] = *(const f32x4*)(xp + 4); }
#pragma unroll
                for (int grp = 0; grp < 8; ++grp) { float* xp = out + (size_t)(TBi * 1024 + wave * 128 + grp * 16 + g4) * DM + col;
#pragma unroll
                    for (int hh = 0; hh < 2; ++hh) { f32x4 xv = xq[grp][hh]; const f32x4 gv = hh ? gv1 : gv0;
#pragma unroll
                        for (int i = 0; i < 4; ++i) xv[i] += gv[i] * acc[grp][4 * hh + i];
                        *(f32x4*)(xp + 4 * hh) = xv; } } }
        }
    }
    }
    SEAM(13);

    if (IN(14)) {
        const _Float16* u16 = (const _Float16*)(ws + WS_UP16);
        const int* OVC = (const int*)(ws + WS_OVC); const unsigned* OVE = (const unsigned*)(ws + WS_OVE); const float* fg = args.in[IN_FG]; float* out = args.out;
        int novN = (gw < NTOK) ? OVC[gw] : 0; u32x4 oN = (gw < NTOK) ? *(const u32x4*)(OVE + (size_t)gw * 256) : (u32x4){0u, 0u, 0u, 0u};
        for (int t = gw; t < NTOK; t += NGW) {
            const int b = t >> 13;
            const int nov = __builtin_amdgcn_readfirstlane(novN); const u32x4 o01 = oN;
            if (t + NGW < NTOK) { novN = OVC[t + NGW]; oN = *(const u32x4*)(OVE + (size_t)(t + NGW) * 256); }
            float xr[32];
#pragma unroll
            for (int j = 0; j < 4; ++j) { const int idx = 8 * (lane + 64 * j); const f32x4 a = *(const f32x4*)(out + (size_t)t * DM + idx), bq = *(const f32x4*)(out + (size_t)t * DM + idx + 4);
#pragma unroll
                for (int i = 0; i < 4; ++i) { xr[8 * j + i] = a[i]; xr[8 * j + 4 + i] = bq[i]; } }
            if (nov > 0) {
                const float* gt2 = MOD + b * 12288 + 5 * DM;
                for (int k0 = 0; k0 < nov; k0 += 2) {
                    half8_t ur[2][4]; float wv[2];
#pragma unroll
                    for (int kk = 0; kk < 2; ++kk) { const bool ok = (k0 + kk < nov); const int k = ok ? k0 + kk : k0;
                        const unsigned eu = (k0 == 0) ? ((kk == 1 && ok) ? o01.z : o01.x) : OVE[((size_t)t * 128 + k) * 2], wu = (k0 == 0) ? ((kk == 1) ? o01.w : o01.y) : OVE[((size_t)t * 128 + k) * 2 + 1];
                        const int e = __builtin_amdgcn_readfirstlane((int)eu); wv[kk] = ok ? __uint_as_float(wu) : 0.f;
#pragma unroll
                        for (int j = 0; j < 4; ++j) ur[kk][j] = *(const half8_t*)(u16 + (size_t)e * DM + 8 * (lane + 64 * j)); }
#pragma unroll
                    for (int kk = 0; kk < 2; ++kk)
#pragma unroll
                        for (int j = 0; j < 4; ++j) { const int idx = 8 * (lane + 64 * j); const f32x4 ga = *(const f32x4*)(gt2 + idx), gb = *(const f32x4*)(gt2 + idx + 4);
#pragma unroll
                            for (int i = 0; i < 4; ++i) { xr[8 * j + i] += ga[i] * wv[kk] * (float)ur[kk][j][i]; xr[8 * j + 4 + i] += gb[i] * wv[kk] * (float)ur[kk][j][4 + i]; } }
                }
            }
            float ss = 0.f;
#pragma unroll
            for (int i = 0; i < 32; ++i) ss += xr[i] * xr[i];
            const float rstd = rsqrtf(wave_sum(ss) * (1.f / DM) + 1e-6f);
#pragma unroll
            for (int j = 0; j < 4; ++j) { const int idx = 8 * (lane + 64 * j);
#pragma unroll
                for (int hh = 0; hh < 2; ++hh) { const f32x4 gq = *(const f32x4*)(fg + idx + 4 * hh); f32x4 o;
#pragma unroll
                    for (int i = 0; i < 4; ++i) o[i] = xr[8 * j + 4 * hh + i] * rstd * gq[i];
                    *(f32x4*)(out + (size_t)t * DM + idx + 4 * hh) = o; } }
        }
    }
#undef IN
#undef SEAM
}

extern "C" void kernel_launch(void* const* d_in, const int* in_sizes, int n_in, void* d_out, int out_size, void* d_ws, size_t ws_size, hipStream_t stream) {
    static int grid = 0;
    if (grid == 0) {
        if (n_in != 20 || out_size != NTOK * DM || ws_size < WS_END) { fprintf(stderr, "kernel_launch: unexpected problem (n_in %d, out %d, ws %zu)\n", n_in, out_size, ws_size); grid = -1; return; }
        int dev = 0, cus = 0, per_cu = 0;
        if (hipGetDevice(&dev) != hipSuccess || hipDeviceGetAttribute(&cus, hipDeviceAttributeMultiprocessorCount, dev) != hipSuccess) { grid = -1; return; }
        if (hipFuncSetAttribute((const void*)fwd_kernel, hipFuncAttributeMaxDynamicSharedMemorySize, LDS_BYTES) != hipSuccess) { fprintf(stderr, "kernel_launch: hipFuncSetAttribute failed\n"); grid = -1; return; }
        if (hipOccupancyMaxActiveBlocksPerMultiprocessor(&per_cu, (const void*)fwd_kernel, NTHR, LDS_BYTES) != hipSuccess || per_cu < 1) { fprintf(stderr, "kernel_launch: occupancy query says %d blocks per CU\n", per_cu); grid = -1; (void)hipGetLastError(); return; }
        grid = cus;
    }
    if (grid < 0) return;
    (void)hipMemsetAsync((char*)d_ws + WS_CTL, 0, 64 * 1024, stream);
    Args a{};
    for (int i = 0; i < 20; ++i) a.in[i] = (const float*)d_in[i];
    a.out = (float*)d_out; a.ws = (unsigned char*)d_ws;
#if MK_N_LAUNCHES == 1
    a.ph_lo = 0; a.ph_hi = NPHASES;
    void* kargs[] = {&a};
    hipError_t e = hipLaunchCooperativeKernel((const void*)fwd_kernel, dim3(grid), dim3(NTHR), kargs, LDS_BYTES, stream);
    if (e != hipSuccess) fprintf(stderr, "kernel_launch: cooperative launch failed: %s (grid %d)\n", hipGetErrorString(e), grid);
#else
    for (int p = 0; p < NPHASES; ++p) { a.ph_lo = p; a.ph_hi = p + 1; hipLaunchKernelGGL(fwd_kernel, dim3(grid), dim3(NTHR), LDS_BYTES, stream, a); }
#endif
}
```

```cpp
#include <hip/hip_runtime.h>
#include <hip/hip_cooperative_groups.h>
#include <cstdio>
#include <cstdint>
namespace cg = cooperative_groups;

#ifndef MK_N_LAUNCHES
#define MK_N_LAUNCHES 1
#endif
#define NPHASES 15

#define LAS __attribute__((address_space(3)))
typedef unsigned short bf16_t;
typedef short bf16x8 __attribute__((ext_vector_type(8)));
typedef float f32x4 __attribute__((ext_vector_type(4)));
typedef unsigned u32x4 __attribute__((ext_vector_type(4)));
typedef unsigned u32x2 __attribute__((ext_vector_type(2)));
typedef __bf16 bf16x2_t __attribute__((ext_vector_type(2)));
typedef _Float16 half8_t __attribute__((ext_vector_type(8)));
typedef _Float16 h2v_t __attribute__((ext_vector_type(2)));

constexpr int DM = 2048, NBATCH = 4, SEQ = 8192, CTXL = 256;
constexpr int NTOK = NBATCH * SEQ;
constexpr int NCTXT = NBATCH * CTXL;
constexpr int MROWS = NTOK + NCTXT;
constexpr int LDP = 10256, NPADW = 10496;
constexpr int C_RQ = 0, C_RK = 512, C_RV = 1024, C_RG = 2048, C_MQ = 3072, C_MK = 3584, C_MV = 4096, C_MO = 5120, C_GR = 6144, C_GM = 8192, C_MG = 10240;
constexpr int NWAVES = 8, NTHR = 512;
constexpr int LDS_BYTES = 160 * 1024;
constexpr int LDS_MISC = 160 * 1024 - 64;
constexpr int LCAP = 12;

constexpr size_t KiB = 1024, MiB = 1024 * 1024;
constexpr size_t WS_CTL = 0;
constexpr size_t WS_MOD = 64 * KiB;
constexpr size_t WS_ROTC = 512 * KiB;
constexpr size_t WS_ROTS = 512 * KiB + 1 * MiB;
constexpr size_t WS_ROWSQ = 2 * MiB + 512 * KiB;
constexpr size_t WS_MSCAL = 6 * MiB + 512 * KiB;
constexpr size_t WS_MPREV = WS_MSCAL + 64 * KiB;
constexpr size_t WS_NLOC = 7 * MiB;
constexpr size_t WS_NPREV = 8 * MiB + 256 * KiB;
constexpr size_t WS_WRO = 10 * MiB;
constexpr size_t WS_WMO = 14 * MiB;
constexpr size_t WS_WO = 18 * MiB;
constexpr size_t WS_WQ = 26 * MiB;
constexpr size_t WS_KEYS = 34 * MiB;
constexpr size_t Z2 = 35 * MiB;
constexpr size_t WS_P = Z2;
constexpr size_t Z3 = 676 * MiB;
constexpr size_t WS_H1 = Z3;
constexpr size_t WS_WINT = Z3 + 132 * MiB;
constexpr size_t WS_PCTX = Z3 + 326 * MiB;
constexpr size_t WS_RST = Z3;
constexpr size_t WS_MST = Z3 + 66 * MiB;
constexpr size_t WS_YRG = Z3 + 198 * MiB;
constexpr size_t WS_YMG = Z3 + 262 * MiB;
constexpr size_t WS_U = Z3;
constexpr size_t WS_X1 = Z3 + 128 * MiB;
constexpr size_t WS_H2 = Z2;
constexpr size_t WS_DN16 = Z2 + 128 * MiB;
constexpr size_t WS_UP16 = Z2 + 192 * MiB;
constexpr size_t WS_Q = Z2 + 256 * MiB;
constexpr size_t WS_EID = Z2 + 384 * MiB;
constexpr size_t WS_GW = Z2 + 400 * MiB;
constexpr size_t WS_IDX = Z2 + 416 * MiB;
constexpr size_t WS_GJ = Z2 + 432 * MiB;
constexpr size_t WS_EW = Z2 + 464 * MiB;
constexpr size_t WS_NMAXG = Z2 + 496 * MiB;
constexpr size_t WS_OVC = Z2 + 497 * MiB;
constexpr size_t WS_OVE = Z2 + 498 * MiB;
constexpr size_t WS_END = 1024 * MiB;

__device__ __forceinline__ float bf2f(unsigned short h) { return __uint_as_float(((unsigned)h) << 16); }
__device__ __forceinline__ unsigned pk2(float lo, float hi) { unsigned r; asm("v_cvt_pk_bf16_f32 %0, %1, %2" : "=v"(r) : "v"(lo), "v"(hi)); return r; }
__device__ __forceinline__ unsigned short f2bf(float f) { return (unsigned short)(pk2(f, 0.f) & 0xffffu); }
__device__ __forceinline__ void unpack8(const u32x4 v, float* f) {
#pragma unroll
    for (int i = 0; i < 4; ++i) { f[2 * i] = __uint_as_float(v[i] << 16); f[2 * i + 1] = __uint_as_float(v[i] & 0xffff0000u); }
}
__device__ __forceinline__ u32x4 pack8(const float* f) { u32x4 o; o.x = pk2(f[0], f[1]); o.y = pk2(f[2], f[3]); o.z = pk2(f[4], f[5]); o.w = pk2(f[6], f[7]); return o; }
__device__ __forceinline__ float sigmoidf_(float x) { return 1.f / (1.f + __expf(-x)); }
__device__ __forceinline__ float logsigf_(float x) { return fminf(x, 0.f) - log1pf(expf(-fabsf(x))); }
__device__ __forceinline__ float wave_sum(float v) {
#pragma unroll
    for (int o = 1; o < 64; o <<= 1) v += __shfl_xor(v, o);
    return v;
}
__device__ __forceinline__ float wave_max(float v) {
#pragma unroll
    for (int o = 1; o < 64; o <<= 1) v = fmaxf(v, __shfl_xor(v, o));
    return v;
}
__device__ __forceinline__ float row16_sum(float v) {
    v += __shfl_xor(v, 1); v += __shfl_xor(v, 2); v += __shfl_xor(v, 4); v += __shfl_xor(v, 8); return v;
}
#define LDS_WAIT() asm volatile("s_waitcnt lgkmcnt(0)" ::: "memory")

namespace pg8 {
constexpr int BM = 256, BK = 64, HALF = 128, HTB = HALF * BK * 2, STAGE_BYTES = 8 * HTB, NXCD = 8, WGM = 8;
__host__ __device__ __forceinline__ int lds_byte(int r, int c) { const int st = (r >> 4) * 2 + (c >> 5), rr = r & 15, cc = c & 31, ob = rr * 64 + cc * 2; return st * 1024 + (ob ^ (((ob >> 9) & 1) << 5)); }
__host__ __device__ __forceinline__ void stage_rc(int b, int& R, int& C) { const int st = b / 1024, sb = b % 1024, swz = sb ^ (((sb >> 9) & 1) << 5); R = (st >> 1) * 16 + swz / 64; C = (st & 1) * 32 + (swz % 64) / 2; }
__host__ __device__ __forceinline__ int perm32(int rho) { const int n = rho >> 4, i = rho & 15; return 8 * (i >> 2) + 4 * n + (i & 3); }
struct Unit { int pm, pn; };
struct Gemm { const bf16_t* A; const bf16_t* Bt; int lda; int K; };

__device__ __forceinline__ void static_map(int L, int nM, int nN, Unit& u) {
    const int nwg = nM * nN; int wgid = L;
    { const int q = nwg / NXCD, r = nwg % NXCD, xcd = wgid % NXCD, off = wgid / NXCD; wgid = (xcd < r ? xcd * (q + 1) : r * (q + 1) + (xcd - r) * q) + off; }
    const int nig = WGM * nN, gid = wgid / nig, fm = gid * WGM, gsz = (nM - fm) < WGM ? (nM - fm) : WGM;
    u.pm = fm + ((wgid % nig) % gsz); u.pn = (wgid % nig) / gsz;
}
struct StaticOrder {
    int nM, nN, nwg, G, c;
    __device__ __forceinline__ void init(int M, int N, int G_, int c_) { nM = M / BM; nN = N / BM; nwg = nM * nN; G = G_; c = c_; }
    __device__ __forceinline__ bool next(int i, Unit& u) const { const long L = (long)i * G + c; if (L >= nwg) return false; static_map((int)L, nM, nN, u); return true; }
};
struct OrderG1 {
    int G, c;
    __device__ __forceinline__ bool next(int i, Unit& u) const {
        const long L = (long)i * G + c;
        if (L < 128 * 41) { static_map((int)L, 128, 41, u); return true; }
        const int j = (int)(L - 128 * 41); if (j >= 52) return false;
        const int t = j >> 2; u.pm = 128 + (j & 3); u.pn = (t < 6) ? (2 + t) : (t < 12 ? 14 + (t - 6) : 40); return true;
    }
};

template <class Epi, class Sched, bool ALIGN_EPI = true, bool SP2 = true>
__device__ __forceinline__ void gemm_phase(LAS unsigned char* lds, const Gemm g, const Sched& S, const Epi& E) {
    const int tid = threadIdx.x, wid = __builtin_amdgcn_readfirstlane(tid >> 6), lane = tid & 63, wr = wid >> 2, wc = wid & 3, fr = lane & 15, fq = lane >> 4;
    const int K = g.K, nt = K / BK, lda = g.lda;
    unsigned voffA[2], voffB[2];
#pragma unroll
    for (int i = 0; i < 2; ++i) { int R, C; stage_rc(tid * 16 + i * 8192, R, C); const int Rb = Epi::PERM ? ((R & ~31) + perm32(R & 31)) : R;
        voffA[i] = (unsigned)(R * lda + C) * 2u; voffB[i] = (unsigned)(Rb * K + C) * 2u; }
    const size_t kstep = (size_t)(BK * 2);
    const size_t hstepA = (size_t)HALF * lda * 2, hstepB = (size_t)HALF * K * 2;
    const size_t tstepA = 2 * hstepA, tstepB = 2 * hstepB;
    const unsigned ldsw = (unsigned)wid * 1024u;
    const int aoff = lds_byte(wr * 64 + fr, fq * 8), boff = lds_byte(wc * 32 + fr, fq * 8);
#define PG8_SA(b, h) (((b) * 2 + (h)) * HTB)
#define PG8_SB(b, h) ((4 + (b) * 2 + (h)) * HTB)
#define PG8_STAGE(bufoff, gbase, voff) do { _Pragma("unroll") for (int _i = 0; _i < 2; ++_i) \
        __builtin_amdgcn_global_load_lds((const unsigned*)((const char*)(gbase) + (voff)[_i]), (LAS unsigned*)(lds + (bufoff) + ldsw + _i * 8192), 16, 0, 0); } while (0)
#define PG8_LDA(dst, b, h) do { _Pragma("unroll") for (int m = 0; m < 4; ++m) _Pragma("unroll") for (int k = 0; k < 2; ++k) dst[m][k] = *(const LAS bf16x8*)(lds + PG8_SA(b, h) + aoff + m * 2048 + k * 1024); } while (0)
#define PG8_LDB(dst, b, h) do { _Pragma("unroll") for (int n = 0; n < 2; ++n) _Pragma("unroll") for (int k = 0; k < 2; ++k) dst[n][k] = *(const LAS bf16x8*)(lds + PG8_SB(b, h) + boff + n * 2048 + k * 1024); } while (0)
#define PG8_MMA(ai, bj, At, Bt) do { __builtin_amdgcn_s_setprio(1); _Pragma("unroll") for (int m = 0; m < 4; ++m) _Pragma("unroll") for (int n = 0; n < 2; ++n) _Pragma("unroll") for (int k = 0; k < 2; ++k) \
        acc[ai][bj][m][n] = __builtin_amdgcn_mfma_f32_16x16x32_bf16(Bt[n][k], At[m][k], acc[ai][bj][m][n], 0, 0, 0); __builtin_amdgcn_s_setprio(0); } while (0)
#define PG8_WAIT_V(n) asm volatile("s_waitcnt vmcnt(" #n ")" ::: "memory")
#define PG8_WAIT_L(n) asm volatile("s_waitcnt lgkmcnt(" #n ")" ::: "memory")
#define PG8_BAR __builtin_amdgcn_s_barrier()
#define PG8_SCHED __builtin_amdgcn_sched_barrier(0)
    Unit cur, nxt; int ui = 0;
    if (!S.next(0, cur)) return;
    f32x4 acc[2][2][4][2];
#pragma unroll
    for (int a = 0; a < 2; ++a)
#pragma unroll
        for (int b = 0; b < 2; ++b)
#pragma unroll
            for (int m = 0; m < 4; ++m)
#pragma unroll
                for (int n = 0; n < 2; ++n) acc[a][b][m][n] = (f32x4){0.f, 0.f, 0.f, 0.f};
    bf16x8 At[4][2], B0[2][2], B1[2][2];
    const char* cA = (const char*)g.A + (size_t)cur.pm * tstepA; const char* cB = (const char*)g.Bt + (size_t)cur.pn * tstepB;
    if constexpr (SP2) {
        PG8_STAGE(PG8_SB(0, 0), cB, voffB); PG8_STAGE(PG8_SB(0, 1), cB + hstepB, voffB); PG8_STAGE(PG8_SA(0, 0), cA, voffA); PG8_STAGE(PG8_SA(0, 1), cA + hstepA, voffA);
        if (wr == 1) PG8_BAR;
        PG8_WAIT_V(2); PG8_BAR;
        PG8_STAGE(PG8_SB(1, 0), cB + kstep, voffB); PG8_STAGE(PG8_SA(1, 0), cA + kstep, voffA); PG8_STAGE(PG8_SB(1, 1), cB + hstepB + kstep, voffB);
        PG8_WAIT_V(6); PG8_BAR;
    } else {
        PG8_STAGE(PG8_SB(0, 0), cB, voffB); PG8_STAGE(PG8_SA(0, 0), cA, voffA); PG8_STAGE(PG8_SB(0, 1), cB + hstepB, voffB); PG8_STAGE(PG8_SA(0, 1), cA + hstepA, voffA);
        if (wr == 1) PG8_BAR;
        PG8_WAIT_V(4); PG8_BAR;
        PG8_STAGE(PG8_SB(1, 0), cB + kstep, voffB); PG8_STAGE(PG8_SA(1, 0), cA + kstep, voffA); PG8_STAGE(PG8_SB(1, 1), cB + hstepB + kstep, voffB);
        PG8_WAIT_V(6); PG8_BAR;
    }
    for (;;) {
        const bool has_next = S.next(ui + 1, nxt);
        const char* nA = has_next ? (const char*)g.A + (size_t)nxt.pm * tstepA : cA; const char* nB = has_next ? (const char*)g.Bt + (size_t)nxt.pn * tstepB : cB;
        for (int t = 0; t < nt; t += 2) {
            const bool last = (t == nt - 2);
            const char* a1 = cA + (size_t)(t + 1) * kstep;
            const char* a2 = last ? nA : cA + (size_t)(t + 2) * kstep; const char* b2 = last ? nB : cB + (size_t)(t + 2) * kstep;
            const char* a3 = a2 + kstep; const char* b3 = b2 + kstep;
            if constexpr (SP2) {
            PG8_LDB(B0, 0, 0); PG8_LDB(B1, 0, 1); PG8_SCHED; PG8_LDA(At, 0, 0); PG8_STAGE(PG8_SA(1, 1), a1 + hstepA, voffA);
            PG8_WAIT_V(8); PG8_WAIT_L(0); PG8_BAR; PG8_MMA(0, 0, At, B0); PG8_MMA(0, 1, At, B1); PG8_BAR; PG8_SCHED;
            PG8_LDA(At, 0, 1); PG8_STAGE(PG8_SB(0, 0), b2, voffB); PG8_STAGE(PG8_SB(0, 1), b2 + hstepB, voffB); PG8_STAGE(PG8_SA(0, 0), a2, voffA);
            PG8_WAIT_V(8); PG8_WAIT_L(0); PG8_BAR; PG8_MMA(1, 0, At, B0); PG8_MMA(1, 1, At, B1); PG8_BAR; PG8_SCHED;
            PG8_LDB(B0, 1, 0); PG8_LDB(B1, 1, 1); PG8_SCHED; PG8_LDA(At, 1, 0); PG8_STAGE(PG8_SA(0, 1), a2 + hstepA, voffA);
            PG8_WAIT_V(8); PG8_WAIT_L(0); PG8_BAR; PG8_MMA(0, 0, At, B0); PG8_MMA(0, 1, At, B1); PG8_BAR; PG8_SCHED;
            PG8_LDA(At, 1, 1); PG8_STAGE(PG8_SB(1, 0), b3, voffB); PG8_STAGE(PG8_SB(1, 1), b3 + hstepB, voffB); PG8_STAGE(PG8_SA(1, 0), a3, voffA);
            PG8_WAIT_V(8); PG8_WAIT_L(0); PG8_BAR; PG8_MMA(1, 0, At, B0); PG8_MMA(1, 1, At, B1); PG8_BAR; PG8_SCHED;
            } else {
            PG8_LDB(B0, 0, 0); PG8_SCHED; PG8_LDA(At, 0, 0); PG8_STAGE(PG8_SA(1, 1), a1 + hstepA, voffA);
            PG8_WAIT_L(8); PG8_BAR; PG8_WAIT_L(0); PG8_MMA(0, 0, At, B0); PG8_BAR; PG8_SCHED;
            PG8_LDB(B1, 0, 1); PG8_STAGE(PG8_SB(0, 0), b2, voffB);
            PG8_BAR; PG8_WAIT_L(0); PG8_MMA(0, 1, At, B1); PG8_BAR;
            PG8_LDA(At, 0, 1); PG8_STAGE(PG8_SA(0, 0), a2, voffA);
            PG8_BAR; PG8_WAIT_L(0); PG8_MMA(1, 0, At, B0); PG8_BAR; PG8_SCHED;
            PG8_STAGE(PG8_SB(0, 1), b2 + hstepB, voffB);
            PG8_WAIT_V(6); PG8_BAR; PG8_MMA(1, 1, At, B1); PG8_BAR;
            PG8_LDB(B0, 1, 0); PG8_SCHED; PG8_LDA(At, 1, 0); PG8_STAGE(PG8_SA(0, 1), a2 + hstepA, voffA);
            PG8_WAIT_L(8); PG8_BAR; PG8_WAIT_L(0); PG8_MMA(0, 0, At, B0); PG8_BAR; PG8_SCHED;
            PG8_LDB(B1, 1, 1); PG8_STAGE(PG8_SB(1, 0), b3, voffB);
            PG8_BAR; PG8_WAIT_L(0); PG8_MMA(0, 1, At, B1); PG8_BAR;
            PG8_LDA(At, 1, 1); PG8_STAGE(PG8_SA(1, 0), a3, voffA);
            PG8_BAR; PG8_WAIT_L(0); PG8_MMA(1, 0, At, B0); PG8_BAR; PG8_SCHED;
            PG8_STAGE(PG8_SB(1, 1), b3 + hstepB, voffB);
            PG8_WAIT_V(6); PG8_BAR; PG8_MMA(1, 1, At, B1); PG8_BAR;
            }
        }
        if constexpr (ALIGN_EPI) { if (wr == 0) PG8_BAR; }
        E(acc, cur, wr, wc, fr, fq);
        if (!has_next) break;
#pragma unroll
        for (int a = 0; a < 2; ++a)
#pragma unroll
            for (int b = 0; b < 2; ++b)
#pragma unroll
                for (int m = 0; m < 4; ++m)
#pragma unroll
                    for (int n = 0; n < 2; ++n) acc[a][b][m][n] = (f32x4){0.f, 0.f, 0.f, 0.f};
        cur = nxt; cA = nA; cB = nB; ++ui;
        if constexpr (ALIGN_EPI) { if (wr == 1) PG8_BAR; }
    }
    PG8_WAIT_V(0);
    if constexpr (!ALIGN_EPI) { if (wr == 0) PG8_BAR; }
    PG8_BAR;
#undef PG8_SA
#undef PG8_SB
#undef PG8_STAGE
#undef PG8_LDA
#undef PG8_LDB
#undef PG8_MMA
#undef PG8_WAIT_V
#undef PG8_WAIT_L
#undef PG8_BAR
#undef PG8_SCHED
}

typedef f32x4 AccT[2][2][4][2];
struct EpiP {
    static constexpr bool PERM = true;
    bf16_t* P; bf16_t* PC;
    __device__ __forceinline__ void operator()(const AccT& acc, const Unit& u, int wr, int wc, int fr, int fq) const {
        const int col0 = u.pn * BM + wc * 32 + 8 * fq;
#pragma unroll
        for (int ai = 0; ai < 2; ++ai)
#pragma unroll
            for (int m = 0; m < 4; ++m) {
                const int row = u.pm * BM + ai * HALF + wr * 64 + m * 16 + fr;
                bf16_t* rp = (row < NTOK) ? P + (size_t)row * LDP : PC + (size_t)(row - NTOK) * LDP;
#pragma unroll
                for (int bj = 0; bj < 2; ++bj) { const int col = col0 + bj * HALF;
                    if (col < LDP) { u32x4 o; o.x = pk2(acc[ai][bj][m][0][0], acc[ai][bj][m][0][1]); o.y = pk2(acc[ai][bj][m][0][2], acc[ai][bj][m][0][3]);
                        o.z = pk2(acc[ai][bj][m][1][0], acc[ai][bj][m][1][1]); o.w = pk2(acc[ai][bj][m][1][2], acc[ai][bj][m][1][3]); *(u32x4*)(rp + col) = o; } }
            }
    }
};
template <int SECOND> struct EpiU {
    static constexpr bool PERM = true;
    const bf16_t* P; bf16_t* U; int gcol;
    __device__ __forceinline__ void operator()(const AccT& acc, const Unit& u, int wr, int wc, int fr, int fq) const {
        const int col0 = u.pn * BM + wc * 32 + 8 * fq;
#pragma unroll
        for (int ai = 0; ai < 2; ++ai) {
            u32x4 gv[4][2], pv[4][2];
#pragma unroll
            for (int m = 0; m < 4; ++m) { const int row = u.pm * BM + ai * HALF + wr * 64 + m * 16 + fr;
#pragma unroll
                for (int bj = 0; bj < 2; ++bj) { const int col = col0 + bj * HALF; gv[m][bj] = *(const u32x4*)(P + (size_t)row * LDP + gcol + col);
                    if (SECOND) pv[m][bj] = *(const u32x4*)(U + (size_t)row * DM + col); } }
#pragma unroll
            for (int m = 0; m < 4; ++m) {
                const int row = u.pm * BM + ai * HALF + wr * 64 + m * 16 + fr;
#pragma unroll
                for (int bj = 0; bj < 2; ++bj) { const int col = col0 + bj * HALF;
                    float gf[8]; unpack8(gv[m][bj], gf);
                    float o[8];
#pragma unroll
                    for (int j = 0; j < 8; ++j) o[j] = sigmoidf_(gf[j]) * acc[ai][bj][m][j >> 2][j & 3];
                    bf16_t* up = U + (size_t)row * DM + col;
                    if (SECOND) { float pf[8]; unpack8(pv[m][bj], pf);
#pragma unroll
                        for (int j = 0; j < 8; ++j) o[j] += pf[j]; }
                    *(u32x4*)up = pack8(o); }
            }
        }
    }
};
struct EpiX1 {
    static constexpr bool PERM = true;
    const float* x; const float* mod; bf16_t* x1; float* rowsq;
    __device__ __forceinline__ void operator()(const AccT& acc, const Unit& u, int wr, int wc, int fr, int fq) const {
        const int col0 = u.pn * BM + wc * 32 + 8 * fq;
        const int b = (u.pm * BM) >> 13;
        f32x4 gq[2][2];
#pragma unroll
        for (int bj = 0; bj < 2; ++bj)
#pragma unroll
            for (int n = 0; n < 2; ++n) gq[bj][n] = *(const f32x4*)(mod + b * 12288 + 2 * DM + col0 + bj * HALF + 4 * n);
#pragma unroll
        for (int am = 0; am < 4; ++am) { const int ai = am >> 1, m0 = (am & 1) * 2;
            f32x4 xq[2][2][2];
#pragma unroll
            for (int mm = 0; mm < 2; ++mm) { const int row = u.pm * BM + ai * HALF + wr * 64 + (m0 + mm) * 16 + fr;
#pragma unroll
                for (int bj = 0; bj < 2; ++bj)
#pragma unroll
                    for (int n = 0; n < 2; ++n) xq[mm][bj][n] = *(const f32x4*)(x + (size_t)row * DM + col0 + bj * HALF + 4 * n); }
#pragma unroll
            for (int mm = 0; mm < 2; ++mm) { const int m = m0 + mm;
                const int row = u.pm * BM + ai * HALF + wr * 64 + m * 16 + fr;
                float ss = 0.f;
#pragma unroll
                for (int bj = 0; bj < 2; ++bj) { const int col = col0 + bj * HALF; float o8[8];
#pragma unroll
                    for (int n = 0; n < 2; ++n) { f32x4 o = xq[mm][bj][n] + gq[bj][n] * acc[ai][bj][m][n];
#pragma unroll
                        for (int i = 0; i < 4; ++i) o8[4 * n + i] = o[i];
                        ss += o[0] * o[0] + o[1] * o[1] + o[2] * o[2] + o[3] * o[3]; }
                    *(u32x4*)(x1 + (size_t)row * DM + col) = pack8(o8); }
                ss += __shfl_xor(ss, 16); ss += __shfl_xor(ss, 32);
                if (fq == 0) rowsq[(size_t)(u.pn * 4 + wc) * NTOK + row] = ss;
            }
        }
    }
};
struct EpiQ {
    static constexpr bool PERM = true;
    bf16_t* O;
    __device__ __forceinline__ void operator()(const AccT& acc, const Unit& u, int wr, int wc, int fr, int fq) const {
        const int col0 = u.pn * BM + wc * 32 + 8 * fq;
#pragma unroll
        for (int ai = 0; ai < 2; ++ai)
#pragma unroll
            for (int m = 0; m < 4; ++m) {
                const int row = u.pm * BM + ai * HALF + wr * 64 + m * 16 + fr;
#pragma unroll
                for (int bj = 0; bj < 2; ++bj) { const int col = col0 + bj * HALF; u32x4 o;
                    o.x = pk2(acc[ai][bj][m][0][0], acc[ai][bj][m][0][1]); o.y = pk2(acc[ai][bj][m][0][2], acc[ai][bj][m][0][3]);
                    o.z = pk2(acc[ai][bj][m][1][0], acc[ai][bj][m][1][1]); o.w = pk2(acc[ai][bj][m][1][2], acc[ai][bj][m][1][3]);
                    *(u32x4*)(O + (size_t)row * DM + col) = o; }
            }
    }
};
}

#define XB_TMO      128
#define XB_XCNT(j)  (256  + 64 * (j))
#define XB_XSUB(j)  (1280 + 64 * (j))
#define XB_XGEN(j)  (2304 + 64 * (j))
#define XB_TOP      3328
#define XB_TOPGEN   3392
#define XCD_BAR_WORDS 3456
#define XB_SPIN_CAP (1u << 20)
__device__ __forceinline__ unsigned xb_ld(unsigned* p)              { return __hip_atomic_load(p, __ATOMIC_RELAXED, __HIP_MEMORY_SCOPE_AGENT); }
__device__ __forceinline__ unsigned xb_add(unsigned* p, unsigned v) { return __hip_atomic_fetch_add(p, v, __ATOMIC_RELAXED, __HIP_MEMORY_SCOPE_AGENT); }
__device__ __forceinline__ unsigned xb_xcc_id() { return (unsigned)__builtin_amdgcn_s_getreg((3 << 11) | 20) & 0xFu; }
#define XB_SPIN(cond, bar) do { unsigned _sp = 0; while (cond) { __builtin_amdgcn_s_sleep(1); \
    if ((++_sp & 255u) == 0u) { if (xb_ld(&(bar)[XB_TMO])) break; if (_sp > XB_SPIN_CAP) { atomicAdd(&(bar)[XB_TMO], 1u); break; } } } } while (0)
struct XcdBarrier { unsigned* bar; unsigned x; volatile LAS unsigned* st; };
__device__ __forceinline__ XcdBarrier xcd_barrier_post(unsigned* bar, volatile LAS unsigned* st) {
    XcdBarrier b; b.bar = bar; b.x = xb_xcc_id(); b.st = st;
    if (threadIdx.x == 0) (void)xb_add(&bar[XB_XCNT(b.x)], 1u);
    return b;
}
__device__ __forceinline__ void xcd_barrier_complete(unsigned* bar, unsigned x, unsigned& nloc, unsigned& nx) {
    const unsigned G = gridDim.x * gridDim.y * gridDim.z;
    unsigned sum, cnt, mine, sp = 0u;
    for (;;) {
        sum = 0u; cnt = 0u; mine = 0u;
#pragma unroll
        for (unsigned j = 0; j < 16; ++j) { const unsigned c = xb_ld(&bar[XB_XCNT(j)]); sum += c; cnt += (c > 0u) ? 1u : 0u; mine = (j == x) ? c : mine; }
        if (sum == G) break;
        __builtin_amdgcn_s_sleep(1);
        if ((++sp & 255u) == 0u) { if (xb_ld(&bar[XB_TMO])) break; if (sp > XB_SPIN_CAP) { atomicAdd(&bar[XB_TMO], 1u); break; } }
    }
    nloc = mine > 0u ? mine : 1u; nx = cnt > 0u ? cnt : 1u;
}
__device__ __forceinline__ void xcd_barrier(const XcdBarrier& b) {
    asm volatile("s_waitcnt vmcnt(0)" ::: "memory");
    __syncthreads();
    if (threadIdx.x == 0) {
        unsigned* bar = b.bar;
        __builtin_amdgcn_s_waitcnt(0);
        unsigned nloc = b.st[0], nx = b.st[1];
        if (nloc == 0u) { xcd_barrier_complete(bar, b.x, nloc, nx); b.st[0] = nloc; b.st[1] = nx; }
        const unsigned old = xb_add(&bar[XB_XSUB(b.x)], 1u);
        const unsigned gen = old / nloc;
        if (old + 1u == (gen + 1u) * nloc) {
            __builtin_amdgcn_fence(__ATOMIC_RELEASE, "agent");
            asm volatile("s_waitcnt vmcnt(0)" ::: "memory");
            const unsigned og = xb_add(&bar[XB_TOP], 1u);
            const unsigned tg = og / nx;
            if (og + 1u == (tg + 1u) * nx) xb_add(&bar[XB_TOPGEN], 1u);
            else XB_SPIN(xb_ld(&bar[XB_TOPGEN]) == tg, bar);
            __builtin_amdgcn_fence(__ATOMIC_ACQUIRE, "agent");
            xb_add(&bar[XB_XGEN(b.x)], 1u);
            asm volatile("s_waitcnt vmcnt(0)" ::: "memory");
        } else {
            XB_SPIN(xb_ld(&bar[XB_XGEN(b.x)]) == gen, bar);
            __builtin_amdgcn_fence(__ATOMIC_ACQUIRE, "agent");
            asm volatile("s_waitcnt vmcnt(0)" ::: "memory");
        }
    }
    __syncthreads();
}

template <int MB, int NBK>
__device__ __forceinline__ void wave_mma(f32x4 (&acc)[MB][NBK], const LAS unsigned char* A, int lda_b, const LAS unsigned char* Bt, int ldb_b, int K, int lane) {
    const int r = lane & 15, q = lane >> 4;
    const LAS unsigned char* ap = A + r * lda_b + q * 16;
    const LAS unsigned char* bp = Bt + r * ldb_b + q * 16;
#pragma unroll 1
    for (int k0 = 0; k0 < K; k0 += 32) {
        bf16x8 a[MB];
#pragma unroll
        for (int mb = 0; mb < MB; ++mb) a[mb] = *(const LAS bf16x8*)(ap + mb * 16 * lda_b + k0 * 2);
#pragma unroll
        for (int nb = 0; nb < NBK; ++nb) { const bf16x8 b = *(const LAS bf16x8*)(bp + nb * 16 * ldb_b + k0 * 2);
#pragma unroll
            for (int mb = 0; mb < MB; ++mb) acc[mb][nb] = __builtin_amdgcn_mfma_f32_16x16x32_bf16(a[mb], b, acc[mb][nb], 0, 0, 0); }
    }
}

struct Args { const float* in[20]; float* out; unsigned char* ws; int ph_lo, ph_hi; };

#define IN_X 0
#define IN_C 1
#define IN_CTX 2
#define IN_CCTX 3
#define IN_WADA 4
#define IN_BADA 5
#define IN_N1G 6
#define IN_WIN 7
#define IN_RDEC 8
#define IN_MCONV 9
#define IN_MGB 10
#define IN_WRO 11
#define IN_WMO 12
#define IN_WO 13
#define IN_N2G 14
#define IN_PQ 15
#define IN_PK 16
#define IN_PD 17
#define IN_PU 18
#define IN_FG 19

template <int MODE>
__device__ __forceinline__ void transpose_item(const float* W, int K, int N, int Npad, bf16_t* WT, LAS float* scr, int item, int lane) {
    const int nblk = Npad / 32, kb = item / nblk, nb = item % nblk, k0 = 64 * kb, n0 = 32 * nb;
    const int n = n0 + (lane & 31);
    int src = n;
    if (MODE == 1) { src = (n < 6144) ? n : (n < 10240 ? n + 16 : (n < 10256 ? n - 10240 + 6144 : -1)); }
#pragma unroll 8
    for (int i = 0; i < 32; ++i) { const int kk = 2 * i + (lane >> 5); scr[kk * 33 + (lane & 31)] = (src >= 0) ? W[(size_t)(k0 + kk) * N + src] : 0.f; }
    LDS_WAIT(); asm volatile("" ::: "memory");
    const int c = lane & 7;
#pragma unroll
    for (int j = 0; j < 4; ++j) { const int nn = (lane >> 3) + 8 * j; const LAS float* s = scr + (8 * c) * 33 + nn;
        u32x4 o; o.x = pk2(s[0 * 33], s[1 * 33]); o.y = pk2(s[2 * 33], s[3 * 33]); o.z = pk2(s[4 * 33], s[5 * 33]); o.w = pk2(s[6 * 33], s[7 * 33]);
        *(u32x4*)(WT + (size_t)(n0 + nn) * K + k0 + 8 * c) = o; }
    LDS_WAIT(); asm volatile("" ::: "memory");
}

__device__ __forceinline__ u32x4 ld16(const bf16_t* p) { return *(const u32x4*)p; }
__device__ __forceinline__ void conv8(const bf16_t* base  , int t, int Ls, const float* w0, const float* w1, const float* w2, float* out) {
    float c[8], p[8], n[8];
    unpack8(ld16(base + (size_t)t * LDP), c);
    if (t > 0) unpack8(ld16(base + (size_t)(t - 1) * LDP), p); else { for (int j = 0; j < 8; ++j) p[j] = 0.f; }
    if (t < Ls - 1) unpack8(ld16(base + (size_t)(t + 1) * LDP), n); else { for (int j = 0; j < 8; ++j) n[j] = 0.f; }
#pragma unroll
    for (int j = 0; j < 8; ++j) { const float pre = w0[j] * p[j] + w1[j] * c[j] + w2[j] * n[j]; out[j] = pre * sigmoidf_(pre); }
}
__device__ __forceinline__ void conv8r(const u32x4 rp, const u32x4 rc, const u32x4 rn, const float* w0, const float* w1, const float* w2, float* out) {
    float c[8], p[8], n[8]; unpack8(rc, c); unpack8(rp, p); unpack8(rn, n);
#pragma unroll
    for (int j = 0; j < 8; ++j) { const float pre = w0[j] * p[j] + w1[j] * c[j] + w2[j] * n[j]; out[j] = pre * sigmoidf_(pre); }
}
__device__ __forceinline__ void conv_rows(const bf16_t* base, int t0, int s0, int Ls, u32x4 (&rows)[4][3]) {
    const u32x4 z = {0u, 0u, 0u, 0u};
#pragma unroll
    for (int i = 0; i < 4; ++i) { const int t = t0 + s0 + 32 * i;
        rows[i][1] = ld16(base + (size_t)t * LDP);
        rows[i][0] = (t > 0) ? ld16(base + (size_t)(t - 1) * LDP) : z;
        rows[i][2] = (t < Ls - 1) ? ld16(base + (size_t)(t + 1) * LDP) : z; }
}
__device__ __forceinline__ void ldw8(const float* p, float* w) { const f32x4 a = *(const f32x4*)p, b = *(const f32x4*)(p + 4); w[0] = a[0]; w[1] = a[1]; w[2] = a[2]; w[3] = a[3]; w[4] = b[0]; w[5] = b[1]; w[6] = b[2]; w[7] = b[3]; }

__device__ __forceinline__ void scan128_sum_prefix(float& lo, float& hi, int lane) {
#pragma unroll
    for (int o = 1; o < 64; o <<= 1) { const float a = __shfl_up(lo, o), b = __shfl_up(hi, o); if (lane >= o) { lo += a; hi += b; } }
    hi += __shfl(lo, 63);
}
__device__ __forceinline__ void scan128_sum_suffix(float& lo, float& hi, int lane) {
#pragma unroll
    for (int o = 1; o < 64; o <<= 1) { const float a = __shfl_down(lo, o), b = __shfl_down(hi, o); if (lane + o < 64) { lo += a; hi += b; } }
    lo += __shfl(hi, 0);
}
__device__ __forceinline__ void scan128_max_prefix(float& lo, float& hi, int lane) {
#pragma unroll
    for (int o = 1; o < 64; o <<= 1) { const float a = __shfl_up(lo, o), b = __shfl_up(hi, o); if (lane >= o) { lo = fmaxf(lo, a); hi = fmaxf(hi, b); } }
    hi = fmaxf(hi, __shfl(lo, 63));
}
__device__ __forceinline__ void scan128_max_suffix(float& lo, float& hi, int lane) {
#pragma unroll
    for (int o = 1; o < 64; o <<= 1) { const float a = __shfl_down(lo, o), b = __shfl_down(hi, o); if (lane + o < 64) { lo = fmaxf(lo, a); hi = fmaxf(hi, b); } }
    lo = fmaxf(lo, __shfl(hi, 0));
}

__device__ __forceinline__ float gelu_erf(float v) { return 0.5f * v * (1.f + erff(v * 0.70710678118654752f)); }

__device__ __forceinline__ float fmix_lo(float w, unsigned h2, float acc) { asm("v_fma_mix_f32 %0, %1, %2, %0 op_sel:[0,0,0] op_sel_hi:[0,1,0]" : "+v"(acc) : "v"(w), "v"(h2)); return acc; }
__device__ __forceinline__ float fmix_hi(float w, unsigned h2, float acc) { asm("v_fma_mix_f32 %0, %1, %2, %0 op_sel:[0,1,0] op_sel_hi:[0,1,0]" : "+v"(acc) : "v"(w), "v"(h2)); return acc; }
#define EBLK(e) ((((unsigned)(e) >> 7) ^ (unsigned)(e)) & 15u)
#define EROWIN(e) ((((unsigned)(e) >> 7) << 3) | (((unsigned)(e) & 127u) >> 4))
#define EROW(ebv, r) ((((r) >> 3) << 7) + (((r) & 7) << 4) + ((((ebv) ^ ((r) >> 3))) & 15))
__device__ __forceinline__ void ins16(float (&L)[16], float x) {
#pragma unroll
    for (int j = 15; j >= 1; --j) L[j] = __builtin_amdgcn_fmed3f(L[j - 1], L[j], x);
    L[0] = fmaxf(L[0], x);
}

__global__ void __launch_bounds__(NTHR, 2) fwd_kernel(Args args) {
    extern __shared__ __attribute__((aligned(16))) unsigned char lds_raw[];
    LAS unsigned char* lds = (LAS unsigned char*)lds_raw;
    const int tid = threadIdx.x, lane = tid & 63, wave = __builtin_amdgcn_readfirstlane(tid >> 6);
    const int G = gridDim.x, bx = blockIdx.x;
    const int gw = bx * NWAVES + wave, NGW = G * NWAVES;
    const int gt = bx * NTHR + tid, NGT = G * NTHR;
    unsigned char* ws = args.ws;
    const int lo = args.ph_lo, hi = args.ph_hi;

    volatile LAS unsigned* MISC = (volatile LAS unsigned*)(lds + LDS_MISC);
    XcdBarrier bar; bar.bar = (unsigned*)(ws + WS_CTL); bar.x = 0; bar.st = MISC;
    const bool fused = (hi - lo) > 1;
    if (fused) {
        if (tid < 4) MISC[tid] = 0u;
        __syncthreads();
        bar = xcd_barrier_post((unsigned*)(ws + WS_CTL), MISC);
    }
#ifndef PH_MASK
#define PH_MASK 0x7FFF
#endif
#define IN(k) (((PH_MASK >> (k)) & 1) && lo <= (k) && (k) < hi)
#ifndef REPEAT_MASK
#define REPEAT_MASK 0
#endif
#define NREP(k) ((((REPEAT_MASK) >> (k)) & 1) ? 2 : 1)
#ifndef VAR_NODMA
#define VAR_NODMA 0
#endif
#ifndef VAR_NOCOMP
#define VAR_NOCOMP 0
#endif
#ifndef VAR_NOAUX
#define VAR_NOAUX 0
#endif
#define VARON(k, f) ((f) && NREP(k) == 2 && rep_ == 0)
#define SEAM(k) do { if (IN(k) && IN((k) + 1)) { if ((k) == 0) { cg::this_grid().sync(); } else { xcd_barrier(bar); } } } while (0)

    float* MOD = (float*)(ws + WS_MOD);
    float* ROTC = (float*)(ws + WS_ROTC); float* ROTS = (float*)(ws + WS_ROTS);
    bf16_t* P = (bf16_t*)(ws + WS_P); bf16_t* PC = (bf16_t*)(ws + WS_PCTX);

    for (int rep_ = 0; rep_ < NREP(0); ++rep_) { if (rep_) xcd_barrier(bar);
    if (IN(0)) {
        const float* c = args.in[IN_C]; const float* cctx = args.in[IN_CCTX]; const float* wada = args.in[IN_WADA]; const float* bada = args.in[IN_BADA];
        LAS float* sc = (LAS float*)lds;
        LAS float* red = (LAS float*)(lds + 40960);
        if (bx < 192) {
            for (int i = tid; i < 5 * DM; i += NTHR) { const float v = (i < 4 * DM) ? c[i] : cctx[i - 4 * DM]; sc[i] = v * sigmoidf_(v); }
            __syncthreads();
        }
        for (int u = bx; u < 192; u += G) {
            const int rg = tid >> 4, cq = tid & 15;
            f32x4 acc[5];
#pragma unroll
            for (int r = 0; r < 5; ++r) acc[r] = (f32x4){0.f, 0.f, 0.f, 0.f};
            for (int k = rg; k < DM; k += 32) { const f32x4 w = *(const f32x4*)(wada + (size_t)k * 12288 + 64 * u + 4 * cq);
#pragma unroll
                for (int r = 0; r < 5; ++r) acc[r] += w * sc[r * DM + k]; }
#pragma unroll
            for (int r = 0; r < 5; ++r)
#pragma unroll
                for (int j = 0; j < 4; ++j) red[(rg * 5 + r) * 64 + 4 * cq + j] = acc[r][j];
            __syncthreads();
            if (tid < 320) { const int r = tid >> 6, j = tid & 63; float s = bada[64 * u + j];
                for (int g2 = 0; g2 < 32; ++g2) s += red[(g2 * 5 + r) * 64 + j];
                MOD[r * 12288 + 64 * u + j] = s; }
            __syncthreads();
        }
        __syncthreads();
        LAS float* scr = (LAS float*)(lds + wave * 16384);
        constexpr int I_IN = 32 * (NPADW / 32), I_RO = 16 * 64, I_O = 32 * 64;
        constexpr int NITEMS = I_IN + 2 * I_RO + 2 * I_O;
        for (int it = gw; it < NITEMS; it += NGW) {
            int r = it;
            if (r < I_IN) { transpose_item<1>(args.in[IN_WIN], DM, LDP, NPADW, (bf16_t*)(ws + WS_WINT), scr, r, lane); continue; } r -= I_IN;
            if (r < I_RO) { transpose_item<0>(args.in[IN_WRO], 1024, DM, DM, (bf16_t*)(ws + WS_WRO), scr, r, lane); continue; } r -= I_RO;
            if (r < I_RO) { transpose_item<0>(args.in[IN_WMO], 1024, DM, DM, (bf16_t*)(ws + WS_WMO), scr, r, lane); continue; } r -= I_RO;
            if (r < I_O) { transpose_item<0>(args.in[IN_WO], DM, DM, DM, (bf16_t*)(ws + WS_WO), scr, r, lane); continue; } r -= I_O;
            transpose_item<0>(args.in[IN_PQ], DM, DM, DM, (bf16_t*)(ws + WS_WQ), scr, r, lane);
        }
        { const float* pk = args.in[IN_PK]; bf16_t* k16 = (bf16_t*)(ws + WS_KEYS);
          for (int i = gt; i < 262144 / 8; i += NGT) { const f32x4 a = *(const f32x4*)(pk + (size_t)i * 8), b = *(const f32x4*)(pk + (size_t)i * 8 + 4);
              u32x4 o; o.x = pk2(a[0], a[1]); o.y = pk2(a[2], a[3]); o.z = pk2(b[0], b[1]); o.w = pk2(b[2], b[3]); *(u32x4*)(k16 + (size_t)i * 8) = o; } }
        for (int i = gt; i < SEQ * 32; i += NGT) { const int t = i >> 5, ii = i & 31, a = ii & 15;
            const float freq = powf(10000.f, -(float)a / 16.f); const float pos = (ii < 16) ? (float)(t >> 6) : (float)(t & 63); const float ang = pos * freq;
            ROTC[i] = cosf(ang); ROTS[i] = sinf(ang); }
    }
    }
    SEAM(0);

    for (int rep_ = 0; rep_ < NREP(1); ++rep_) { if (rep_) xcd_barrier(bar);
    if (IN(1)) {
        const float* x = args.in[IN_X]; const float* ctx = args.in[IN_CTX]; const float* g1 = args.in[IN_N1G]; bf16_t* H1 = (bf16_t*)(ws + WS_H1);
        for (int row = gw; row < MROWS; row += NGW) {
            const float* src = (row < NTOK) ? x + (size_t)row * DM : ctx + (size_t)(row - NTOK) * DM; const int r = (row < NTOK) ? (row >> 13) : 4;
            f32x4 v[8]; float ss = 0.f;
#pragma unroll
            for (int j = 0; j < 8; ++j) { v[j] = *(const f32x4*)(src + 4 * (lane + 64 * j)); ss += v[j][0] * v[j][0] + v[j][1] * v[j][1] + v[j][2] * v[j][2] + v[j][3] * v[j][3]; }
            const float* shp = MOD + r * 12288; const float* scp = shp + DM;
            f32x4 gq[8], shq[8], scq[8];
#pragma unroll
            for (int j = 0; j < 8; ++j) { const int idx = 4 * (lane + 64 * j); gq[j] = *(const f32x4*)(g1 + idx); shq[j] = *(const f32x4*)(shp + idx); scq[j] = *(const f32x4*)(scp + idx); }
            const float rstd = rsqrtf(wave_sum(ss) * (1.f / DM) + 1e-6f);
#pragma unroll
            for (int j = 0; j < 8; ++j) { const int idx = 4 * (lane + 64 * j);
                const f32x4 h = v[j] * rstd * gq[j] * (scq[j] + 1.f) + shq[j]; u32x2 o; o.x = pk2(h[0], h[1]); o.y = pk2(h[2], h[3]); *(u32x2*)(H1 + (size_t)row * DM + idx) = o; }
        }
    }
    }
    SEAM(1);

    for (int rep_ = 0; rep_ < NREP(2); ++rep_) { if (rep_) xcd_barrier(bar);
    if (IN(2)) {
        pg8::Gemm g{(const bf16_t*)(ws + WS_H1), (const bf16_t*)(ws + WS_WINT), DM, DM}; pg8::OrderG1 S{G, bx}; pg8::EpiP E{P, PC};
        pg8::gemm_phase<pg8::EpiP, pg8::OrderG1>(lds, g, S, E);
    }
    }
    SEAM(2);

    const float* rdec = args.in[IN_RDEC]; const float* mconv = args.in[IN_MCONV]; const float* mgb = args.in[IN_MGB];
    bf16_t* RST = (bf16_t*)(ws + WS_RST); bf16_t* MST = (bf16_t*)(ws + WS_MST);
    float* MSCAL = (float*)(ws + WS_MSCAL); float* MPREV = (float*)(ws + WS_MPREV); float* NLOC = (float*)(ws + WS_NLOC); float* NPREV = (float*)(ws + WS_NPREV);

    for (int rep_ = 0; rep_ < NREP(3); ++rep_) { if (rep_) xcd_barrier(bar);
    if (IN(3)) {
        for (int u = bx; u < 1056 + 2112; u += G) {
            int tid = threadIdx.x; asm volatile("" : "+v"(tid)); const int lane = tid & 63;
            if (u < 1056) {
                const int bh = u / 66, cc = u % 66, b = bh >> 2, h = bh & 3;
                const bool ctxu = cc >= 64; const int Ls = ctxu ? CTXL : SEQ; const int t0 = ctxu ? (cc - 64) * 128 : cc * 128;
                const bf16_t* Pb = ctxu ? PC + (size_t)(b * CTXL) * LDP : P + (size_t)(b * SEQ) * LDP;
                LAS unsigned char* KWT = lds;
                LAS unsigned char* VT = lds + 69632;
                LAS float* WTS = (LAS float*)(lds + 104448);
                if (wave < 2) {
                    const int dir = wave;
                    const float bi = mgb[dir * 8 + h], bfv = mgb[dir * 8 + 4 + h];
                    const bf16_t* gp = Pb + (size_t)t0 * LDP + C_MG + dir * 8 + h;
                    const float i_lo = bf2f(gp[(size_t)lane * LDP]) + bi, i_hi = bf2f(gp[(size_t)(lane + 64) * LDP]) + bi;
                    const float f_lo = logsigf_(bf2f(gp[(size_t)lane * LDP + 4]) + bfv), f_hi = logsigf_(bf2f(gp[(size_t)(lane + 64) * LDP + 4]) + bfv);
                    float c_lo = f_lo, c_hi = f_hi, bend;
                    if (dir == 0) { scan128_sum_prefix(c_lo, c_hi, lane); bend = __shfl(c_hi, 63); }
                    else { scan128_sum_suffix(c_lo, c_hi, lane); bend = __shfl(c_lo, 0); }
                    const float w_lo = bend - c_lo + i_lo, w_hi = bend - c_hi + i_hi;
                    const float M = wave_max(fmaxf(w_lo, w_hi));
                    WTS[dir * 128 + lane] = __expf(w_lo - M); WTS[dir * 128 + 64 + lane] = __expf(w_hi - M);
                    if (lane == 0) { MSCAL[((dir * 16 + bh) * 66 + cc) * 2] = M; MSCAL[((dir * 16 + bh) * 66 + cc) * 2 + 1] = bend; }
                }
                __syncthreads();
                {   const int ch = (tid >> 5) * 8, s0 = tid & 31;
                    float w0[8], w1[8], w2[8]; const float* wp = mconv + 512 + h * 128 + ch; ldw8(wp, w0); ldw8(wp + 1024, w1); ldw8(wp + 2048, w2);
                    u32x4 rows[4][3]; conv_rows(Pb + C_MK + h * 128 + ch, t0, s0, Ls, rows);
#pragma unroll
                    for (int i = 0; i < 4; ++i) { const int s = s0 + 32 * i; float kv[8]; conv8r(rows[i][0], rows[i][1], rows[i][2], w0, w1, w2, kv);
                        const float wf = WTS[s] * 0.08838834764831845f, wb = WTS[128 + s] * 0.08838834764831845f;
#pragma unroll
                        for (int j = 0; j < 8; ++j) { *(LAS bf16_t*)(KWT + ((ch + j) * 136 + s) * 2) = f2bf(kv[j] * wf); *(LAS bf16_t*)(KWT + ((128 + ch + j) * 136 + s) * 2) = f2bf(kv[j] * wb); } } }
#pragma unroll 1
                for (int half = 0; half < 2; ++half) {
                    __syncthreads();
                    { u32x4 raw_[4];
#pragma unroll
                    for (int i = 0; i < 4; ++i) { const int task = tid + NTHR * i, s = task & 127, e8 = (task >> 7) * 8; raw_[i] = ld16(Pb + (size_t)(t0 + s) * LDP + C_MV + h * 256 + half * 128 + e8); }
#pragma unroll
                    for (int i = 0; i < 4; ++i) { const int task = tid + NTHR * i, s = task & 127, e8 = (task >> 7) * 8; const u32x4 v = raw_[i];
#pragma unroll
                        for (int j = 0; j < 4; ++j) { *(LAS bf16_t*)(VT + ((e8 + 2 * j) * 136 + s) * 2) = (bf16_t)(v[j] & 0xffffu); *(LAS bf16_t*)(VT + ((e8 + 2 * j + 1) * 136 + s) * 2) = (bf16_t)(v[j] >> 16); } } }
                    __syncthreads();
                    if (half == 0 && tid < 256) { float s = 0.f; const LAS bf16_t* rp = (const LAS bf16_t*)(KWT + tid * 272);
                        for (int k = 0; k < 128; ++k) s += bf2f(rp[k]);
                        NLOC[(((tid >> 7) * 16 + bh) * 66 + cc) * 128 + (tid & 127)] = s; }
                    f32x4 acc[2][8];
#pragma unroll
                    for (int a = 0; a < 2; ++a)
#pragma unroll
                        for (int n = 0; n < 8; ++n) acc[a][n] = (f32x4){0.f, 0.f, 0.f, 0.f};
                    {   f32x4 (&a0)[1][8] = *reinterpret_cast<f32x4 (*)[1][8]>(&acc[0]); f32x4 (&a1)[1][8] = *reinterpret_cast<f32x4 (*)[1][8]>(&acc[1]);
                        wave_mma<1, 8>(a0, KWT + (16 * wave) * 272, 272, VT, 272, 128, lane);
                        wave_mma<1, 8>(a1, KWT + (128 + 16 * wave) * 272, 272, VT, 272, 128, lane); }
                    const int r = lane & 15, q = lane >> 4;
#pragma unroll
                    for (int dir = 0; dir < 2; ++dir)
#pragma unroll
                        for (int nb = 0; nb < 8; ++nb) { const int e = half * 128 + nb * 16 + r, d = 16 * wave + q * 4;
                            u32x2 o; o.x = pk2(acc[dir][nb][0], acc[dir][nb][1]); o.y = pk2(acc[dir][nb][2], acc[dir][nb][3]);
                            *(u32x2*)(MST + ((size_t)((dir * 16 + bh) * 66 + cc) * 256 + e) * 128 + d) = o; }
                }
                __syncthreads();
            } else {
                const int v = u - 1056; const int bh = v / 66, cc = v % 66, b = bh >> 3, h = bh & 7;
                const bool ctxu = cc >= 64; const int t0 = ctxu ? (cc - 64) * 128 : cc * 128;
                const bf16_t* Pb = ctxu ? PC + (size_t)(b * CTXL) * LDP : P + (size_t)(b * SEQ) * LDP;
                LAS unsigned char* KT = lds;
                LAS unsigned char* VT = lds + 34816;
                const float lgf = logsigf_(rdec[h]), lgb = logsigf_(rdec[8 + h]);
                { u32x4 raw_[4];
#pragma unroll
                for (int i = 0; i < 4; ++i) { const int task = tid + NTHR * i, s = task & 127, e8 = (task >> 7) * 8; raw_[i] = ld16(Pb + (size_t)(t0 + s) * LDP + C_RV + h * 128 + e8); }
#pragma unroll
                for (int i = 0; i < 4; ++i) { const int task = tid + NTHR * i, s = task & 127, e8 = (task >> 7) * 8; const u32x4 vv = raw_[i];
#pragma unroll
                    for (int j = 0; j < 4; ++j) { *(LAS bf16_t*)(VT + ((e8 + 2 * j) * 136 + s) * 2) = (bf16_t)(vv[j] & 0xffffu); *(LAS bf16_t*)(VT + ((e8 + 2 * j + 1) * 136 + s) * 2) = (bf16_t)(vv[j] >> 16); } } }
                {   const int s = tid & 127, ic = (tid >> 7) * 8; float k1[8], k2[8];
                    const bf16_t* kp = Pb + (size_t)(t0 + s) * LDP + C_RK + h * 64 + ic; unpack8(ld16(kp), k1); unpack8(ld16(kp + 32), k2);
                    const float df = __expf(lgf * (float)(127 - s)) * 0.125f, db = __expf(lgb * (float)s) * 0.125f;
#pragma unroll
                    for (int j = 0; j < 8; ++j) { float r1 = k1[j], r2 = k2[j];
                        if (!ctxu) { const float cs = ROTC[(t0 + s) * 32 + ic + j], sn = ROTS[(t0 + s) * 32 + ic + j]; r1 = k1[j] * cs - k2[j] * sn; r2 = k2[j] * cs + k1[j] * sn; }
                        *(LAS bf16_t*)(KT + ((ic + j) * 136 + s) * 2) = f2bf(r1 * df); *(LAS bf16_t*)(KT + ((32 + ic + j) * 136 + s) * 2) = f2bf(r2 * df);
                        *(LAS bf16_t*)(KT + ((64 + ic + j) * 136 + s) * 2) = f2bf(r1 * db); *(LAS bf16_t*)(KT + ((96 + ic + j) * 136 + s) * 2) = f2bf(r2 * db); } }
                __syncthreads();
                f32x4 acc[1][8];
#pragma unroll
                for (int n = 0; n < 8; ++n) acc[0][n] = (f32x4){0.f, 0.f, 0.f, 0.f};
                wave_mma<1, 8>(acc, KT + (16 * wave) * 272, 272, VT, 272, 128, lane);
                const int r = lane & 15, q = lane >> 4, dir = wave >> 2, d = ((16 * wave) & 63) + q * 4;
#pragma unroll
                for (int nb = 0; nb < 8; ++nb) { const int e = nb * 16 + r; u32x2 o; o.x = pk2(acc[0][nb][0], acc[0][nb][1]); o.y = pk2(acc[0][nb][2], acc[0][nb][3]);
                    *(u32x2*)(RST + ((size_t)((dir * 32 + bh) * 66 + cc) * 128 + e) * 64 + d) = o; }
                __syncthreads();
            }
        }
    }
    }
    SEAM(3);

    for (int rep_ = 0; rep_ < NREP(4); ++rep_) { if (rep_) xcd_barrier(bar);
    if (IN(4)) {
        for (int task = gt; task < 65536; task += NGT) {
            const int dc = task & 7, e = (task >> 3) & 127, bh = (task >> 10) & 31, dir = task >> 15, h = bh & 7;
            const float g = expf(128.f * logsigf_(rdec[dir * 8 + h]));
            bf16_t* base = RST + (size_t)((dir * 32 + bh) * 66) * 8192 + e * 64 + dc * 8;
            float S[8], v[8];
#pragma unroll
            for (int j = 0; j < 8; ++j) S[j] = 0.f;
            for (int k = 0; k < 2; ++k) { const int cc = dir ? (65 - k) : (64 + k); unpack8(ld16(base + (size_t)cc * 8192), v);
#pragma unroll
                for (int j = 0; j < 8; ++j) S[j] = g * S[j] + v[j]; }
#pragma unroll 1
            for (int kb = 0; kb < 64; kb += 8) { u32x4 raw[8];
#pragma unroll
                for (int kk = 0; kk < 8; ++kk) { const int c = dir ? (63 - kb - kk) : (kb + kk); raw[kk] = ld16(base + (size_t)c * 8192); }
#pragma unroll
                for (int kk = 0; kk < 8; ++kk) { const int c = dir ? (63 - kb - kk) : (kb + kk); unpack8(raw[kk], v); *(u32x4*)(base + (size_t)c * 8192) = pack8(S);
#pragma unroll
                    for (int j = 0; j < 8; ++j) S[j] = g * S[j] + v[j]; } }
        }
        for (int task = gt; task < 131072; task += NGT) {
            const int dc = task & 15, e = (task >> 4) & 255, bh = (task >> 12) & 15, dir = task >> 16;
            bf16_t* base = MST + (size_t)((dir * 16 + bh) * 66) * 32768 + e * 128 + dc * 8;
            const float* scp = MSCAL + (size_t)((dir * 16 + bh) * 66) * 2;
            float S[8], v[8], m = 0.f;
#pragma unroll
            for (int j = 0; j < 8; ++j) S[j] = 0.f;
            for (int k = 0; k < 2; ++k) { const int cc = dir ? (65 - k) : (64 + k); unpack8(ld16(base + (size_t)cc * 32768), v);
                const float M = scp[cc * 2], be = scp[cc * 2 + 1], mn = fmaxf(be + m, M), cS = expf(be + m - mn), cK = expf(M - mn);
#pragma unroll
                for (int j = 0; j < 8; ++j) S[j] = cS * S[j] + cK * v[j];
                m = mn; }
#pragma unroll 1
            for (int kb = 0; kb < 64; kb += 8) { u32x4 raw[8];
#pragma unroll
                for (int kk = 0; kk < 8; ++kk) { const int c = dir ? (63 - kb - kk) : (kb + kk); raw[kk] = ld16(base + (size_t)c * 32768); }
#pragma unroll
                for (int kk = 0; kk < 8; ++kk) { const int c = dir ? (63 - kb - kk) : (kb + kk); unpack8(raw[kk], v); *(u32x4*)(base + (size_t)c * 32768) = pack8(S);
                    if (e == 0 && dc == 0) MPREV[(dir * 16 + bh) * 64 + c] = m;
                    const float M = scp[c * 2], be = scp[c * 2 + 1], mn = fmaxf(be + m, M), cS = __expf(be + m - mn), cK = __expf(M - mn);
#pragma unroll
                    for (int j = 0; j < 8; ++j) S[j] = cS * S[j] + cK * v[j];
                    m = mn; } }
        }
        for (int task = gt; task < 4096; task += NGT) {
            const int d = task & 127, bh = (task >> 7) & 15, dir = task >> 11;
            const float* nl = NLOC + (size_t)((dir * 16 + bh) * 66) * 128 + d; float* np = NPREV + (size_t)((dir * 16 + bh) * 64) * 128 + d;
            const float* scp = MSCAL + (size_t)((dir * 16 + bh) * 66) * 2;
            float S = 0.f, m = 0.f;
            for (int k = 0; k < 2; ++k) { const int cc = dir ? (65 - k) : (64 + k);
                const float M = scp[cc * 2], be = scp[cc * 2 + 1], mn = fmaxf(be + m, M); S = expf(be + m - mn) * S + expf(M - mn) * nl[cc * 128]; m = mn; }
            for (int k = 0; k < 64; ++k) { const int c = dir ? (63 - k) : k; np[c * 128] = S;
                const float M = scp[c * 2], be = scp[c * 2 + 1], mn = fmaxf(be + m, M); S = expf(be + m - mn) * S + expf(M - mn) * nl[c * 128]; m = mn; }
        }
    }
    }
    SEAM(4);

    for (int rep_ = 0; rep_ < NREP(5); ++rep_) { if (rep_) xcd_barrier(bar);
    if (IN(5)) {
        bf16_t* YRG = (bf16_t*)(ws + WS_YRG); bf16_t* YMG = (bf16_t*)(ws + WS_YMG);
        for (int u = bx; u < 1024 + 2048; u += G) {
            int tid = threadIdx.x; asm volatile("" : "+v"(tid)); const int lane = tid & 63;
            const int r = lane & 15, q = lane >> 4;
            if (u < 1024) {
                const int bh = u >> 6, c = u & 63, b = bh >> 2, h = bh & 3, t0 = c * 128;
                const bf16_t* Pb = P + (size_t)(b * SEQ) * LDP;
                LAS unsigned char* Qs = lds;
                LAS unsigned char* Ks = lds + 34816;
                LAS unsigned char* ATT = lds + 73984;
                LAS unsigned char* R3 = lds + 108800;
                LAS float* ARR = (LAS float*)(lds + 143616);
                LAS float *ERF = ARR, *ECF = ARR + 128, *INF = ARR + 256, *EMF = ARR + 384, *ERB = ARR + 512, *ECB = ARR + 640, *INB = ARR + 768, *EMB = ARR + 896, *CF = ARR + 1024, *CB = ARR + 1152;
                if (wave < 2) {
                    const int dir = wave;
                    const float bi = mgb[dir * 8 + h], bfv = mgb[dir * 8 + 4 + h], mprev = MPREV[(dir * 16 + bh) * 64 + c];
                    const bf16_t* gp = Pb + (size_t)t0 * LDP + C_MG + dir * 8 + h;
                    const float i_lo = bf2f(gp[(size_t)lane * LDP]) + bi, i_hi = bf2f(gp[(size_t)(lane + 64) * LDP]) + bi;
                    const float f_lo = logsigf_(bf2f(gp[(size_t)lane * LDP + 4]) + bfv), f_hi = logsigf_(bf2f(gp[(size_t)(lane + 64) * LDP + 4]) + bfv);
                    float c_lo = f_lo, c_hi = f_hi;
                    if (dir == 0) scan128_sum_prefix(c_lo, c_hi, lane); else scan128_sum_suffix(c_lo, c_hi, lane);
                    const float ec_lo = i_lo - c_lo, ec_hi = i_hi - c_hi;
                    float g_lo = ec_lo, g_hi = ec_hi;
                    if (dir == 0) scan128_max_prefix(g_lo, g_hi, lane); else scan128_max_suffix(g_lo, g_hi, lane);
                    const float mt_lo = c_lo + fmaxf(mprev, g_lo), mt_hi = c_hi + fmaxf(mprev, g_hi);
                    LAS float* ER = dir ? ERB : ERF; LAS float* EC = dir ? ECB : ECF; LAS float* INr = dir ? INB : INF; LAS float* EM = dir ? EMB : EMF;
                    ER[lane] = c_lo - mt_lo; ER[lane + 64] = c_hi - mt_hi; EC[lane] = ec_lo; EC[lane + 64] = ec_hi;
                    INr[lane] = __expf(c_lo + mprev - mt_lo); INr[lane + 64] = __expf(c_hi + mprev - mt_hi); EM[lane] = __expf(-mt_lo); EM[lane + 64] = __expf(-mt_hi);
                }
                {   const int ch = (tid >> 5) * 8, s0 = tid & 31; float w0[8], w1[8], w2[8], o[8]; u32x4 rows[4][3];
                    const float* wq = mconv + h * 128 + ch; ldw8(wq, w0); ldw8(wq + 1024, w1); ldw8(wq + 2048, w2);
                    conv_rows(Pb + C_MQ + h * 128 + ch, t0, s0, SEQ, rows);
#pragma unroll
                    for (int i = 0; i < 4; ++i) { conv8r(rows[i][0], rows[i][1], rows[i][2], w0, w1, w2, o); *(LAS u32x4*)(Qs + (s0 + 32 * i) * 272 + ch * 2) = pack8(o); }
                    const float* wk = mconv + 512 + h * 128 + ch; ldw8(wk, w0); ldw8(wk + 1024, w1); ldw8(wk + 2048, w2);
                    conv_rows(Pb + C_MK + h * 128 + ch, t0, s0, SEQ, rows);
#pragma unroll
                    for (int i = 0; i < 4; ++i) { conv8r(rows[i][0], rows[i][1], rows[i][2], w0, w1, w2, o);
#pragma unroll
                        for (int j = 0; j < 8; ++j) o[j] *= 0.08838834764831845f;
                        *(LAS u32x4*)(Ks + (s0 + 32 * i) * 272 + ch * 2) = pack8(o); } }
                if (tid < 256) { const int rowi = tid >> 4, dch = (tid & 15) * 8; float o[8];
#pragma unroll
                    for (int j = 0; j < 8; ++j) o[j] = (rowi < 2) ? NPREV[(size_t)((rowi * 16 + bh) * 64 + c) * 128 + dch + j] : 0.f;
                    *(LAS u32x4*)(Ks + (128 + rowi) * 272 + dch * 2) = pack8(o); }
                { u32x4 raw_[4];
#pragma unroll
                for (int i = 0; i < 4; ++i) { const int task = tid + NTHR * i, s = task & 127, e8 = (task >> 7) * 8; raw_[i] = ld16(Pb + (size_t)(t0 + s) * LDP + C_MV + h * 256 + e8); }
#pragma unroll
                for (int i = 0; i < 4; ++i) { const int task = tid + NTHR * i, s = task & 127, e8 = (task >> 7) * 8; const u32x4 v = raw_[i];
#pragma unroll
                    for (int j = 0; j < 4; ++j) { *(LAS bf16_t*)(R3 + ((e8 + 2 * j) * 136 + s) * 2) = (bf16_t)(v[j] & 0xffffu); *(LAS bf16_t*)(R3 + ((e8 + 2 * j + 1) * 136 + s) * 2) = (bf16_t)(v[j] >> 16); } } }
                __syncthreads();
                {   f32x4 qk[1][9];
#pragma unroll
                    for (int n = 0; n < 9; ++n) qk[0][n] = (f32x4){0.f, 0.f, 0.f, 0.f};
                    wave_mma<1, 9>(qk, Qs + (16 * wave) * 272, 272, Ks, 272, 128, lane);
#pragma unroll
                    for (int j = 0; j < 4; ++j) { const int p = 16 * wave + q * 4 + j;
                        const float erf_ = ERF[p], erb_ = ERB[p];
                        float af[8], ab[8], rsf = 0.f, rsb = 0.f;
#pragma unroll
                        for (int nb = 0; nb < 8; ++nb) { const int s = nb * 16 + r; const float xv = qk[0][nb][j];
                            af[nb] = (s <= p) ? xv * __expf(erf_ + ECF[s]) : 0.f; ab[nb] = (s >= p) ? xv * __expf(erb_ + ECB[s]) : 0.f; rsf += af[nb]; rsb += ab[nb]; }
                        rsf = row16_sum(rsf); rsb = row16_sum(rsb);
                        const float qnf = __shfl(qk[0][8][j], q * 16), qnb = __shfl(qk[0][8][j], q * 16 + 1);
                        const float inf_ = INF[p], inb_ = INB[p];
                        const float dnf = fmaxf(fabsf(rsf + inf_ * qnf), EMF[p]), dnb = fmaxf(fabsf(rsb + inb_ * qnb), EMB[p]);
                        const float rf = 1.f / dnf, rb = 1.f / dnb;
#pragma unroll
                        for (int nb = 0; nb < 8; ++nb) *(LAS bf16_t*)(ATT + (p * 136 + nb * 16 + r) * 2) = f2bf(af[nb] * rf + ab[nb] * rb);
                        if (r == 0) { CF[p] = inf_ * rf; CB[p] = inb_ * rb; }
                        __builtin_amdgcn_sched_barrier(0); }
                }
                __syncthreads();
                f32x4 y[2][1][8];
#pragma unroll
                for (int a = 0; a < 2; ++a)
#pragma unroll
                    for (int n = 0; n < 8; ++n) y[a][0][n] = (f32x4){0.f, 0.f, 0.f, 0.f};
                wave_mma<1, 8>(y[0], ATT + (16 * wave) * 272, 272, R3, 272, 128, lane);
                __syncthreads();
                { u32x4 raw_[4];
#pragma unroll
                for (int i = 0; i < 4; ++i) { const int task = tid + NTHR * i, s = task & 127, e8 = (task >> 7) * 8; raw_[i] = ld16(Pb + (size_t)(t0 + s) * LDP + C_MV + h * 256 + 128 + e8); }
#pragma unroll
                for (int i = 0; i < 4; ++i) { const int task = tid + NTHR * i, s = task & 127, e8 = (task >> 7) * 8; const u32x4 v = raw_[i];
#pragma unroll
                    for (int j = 0; j < 4; ++j) { *(LAS bf16_t*)(R3 + ((e8 + 2 * j) * 136 + s) * 2) = (bf16_t)(v[j] & 0xffffu); *(LAS bf16_t*)(R3 + ((e8 + 2 * j + 1) * 136 + s) * 2) = (bf16_t)(v[j] >> 16); } } }
                __syncthreads();
                wave_mma<1, 8>(y[1], ATT + (16 * wave) * 272, 272, R3, 272, 128, lane);
#pragma unroll 1
                for (int dir = 0; dir < 2; ++dir) {
                    __syncthreads();
                    {   LAS float* CX = dir ? CB : CF;
#pragma unroll 1
                        for (int i = 0; i < 4; ++i) { const int task = tid + NTHR * i, s = task >> 4, ch = (task & 15) * 8; float o[8];
                            unpack8(*(const LAS u32x4*)(Qs + s * 272 + ch * 2), o); const float cx = CX[s];
#pragma unroll
                            for (int j = 0; j < 8; ++j) o[j] *= cx;
                            *(LAS u32x4*)(Ks + s * 272 + ch * 2) = pack8(o); } }
#pragma unroll 1
                    for (int half = 0; half < 2; ++half) {
                        if (half) __syncthreads();
                        { u32x4 raw_[4];
#pragma unroll
                        for (int i = 0; i < 4; ++i) { const int task = tid + NTHR * i, e = task >> 4, dch = (task & 15) * 8; raw_[i] = ld16(MST + ((size_t)((dir * 16 + bh) * 66 + c) * 256 + half * 128 + e) * 128 + dch); }
#pragma unroll
                        for (int i = 0; i < 4; ++i) { const int task = tid + NTHR * i, e = task >> 4, dch = (task & 15) * 8; *(LAS u32x4*)(R3 + e * 272 + dch * 2) = raw_[i]; } }
                        __syncthreads();
                        if (half == 0) wave_mma<1, 8>(y[0], Ks + (16 * wave) * 272, 272, R3, 272, 128, lane);
                        else wave_mma<1, 8>(y[1], Ks + (16 * wave) * 272, 272, R3, 272, 128, lane);
                    }
                }
                __syncthreads();
#pragma unroll
                for (int j = 0; j < 4; ++j) { const int p = 16 * wave + q * 4 + j;
                    float s1 = 0.f;
#pragma unroll
                    for (int nb = 0; nb < 8; ++nb) s1 += y[0][0][nb][j] + y[1][0][nb][j];
                    const float mean = row16_sum(s1) * (1.f / 256.f);
                    float s2 = 0.f;
#pragma unroll
                    for (int nb = 0; nb < 8; ++nb) { const float a = y[0][0][nb][j] - mean, bb = y[1][0][nb][j] - mean; s2 += a * a + bb * bb; }
                    const float rstd = rsqrtf(row16_sum(s2) * (1.f / 256.f) + 1e-6f);
#pragma unroll
                    for (int half = 0; half < 2; ++half)
#pragma unroll
                        for (int nb = 0; nb < 8; ++nb) { const int e = half * 128 + nb * 16 + r;
                            *(LAS bf16_t*)(Qs + (p * 264 + e) * 2) = f2bf((y[half][0][nb][j] - mean) * rstd); } }
                __syncthreads();
                {   u32x4 gr_[8];
#pragma unroll
                    for (int i = 0; i < 8; ++i) { const int task = tid + NTHR * i, p = task >> 5, e8 = (task & 31) * 8; gr_[i] = ld16(P + (size_t)(b * SEQ + t0 + p) * LDP + C_MO + h * 256 + e8); }
#pragma unroll
                    for (int i = 0; i < 8; ++i) { const int task = tid + NTHR * i, p = task >> 5, e8 = (task & 31) * 8; float yv[8], gv[8];
                        unpack8(*(const LAS u32x4*)(Qs + (p * 264 + e8) * 2), yv); unpack8(gr_[i], gv);
#pragma unroll
                        for (int jj = 0; jj < 8; ++jj) yv[jj] *= sigmoidf_(gv[jj]);
                        *(u32x4*)(YMG + (size_t)(b * SEQ + t0 + p) * 1024 + h * 256 + e8) = pack8(yv); } }
                __syncthreads();
            } else {
                const int v = u - 1024; const int bh = v >> 6, c = v & 63, b = bh >> 3, h = bh & 7, t0 = c * 128;
                const bf16_t* Pb = P + (size_t)(b * SEQ) * LDP;
                LAS unsigned char* Qs = lds;
                LAS unsigned char* Ks = lds + 18432;
                LAS unsigned char* AP = lds;
                LAS unsigned char* ATT = lds + 36864;
                LAS unsigned char* VT = lds + 71680;
                LAS unsigned char* ST = lds + 106496;
                const float lgf = logsigf_(rdec[h]), lgb = logsigf_(rdec[8 + h]);
                {   const int s = tid >> 2, ic = (tid & 3) * 8; float a1[8], a2[8], k1[8], k2[8], o1[8], o2[8];
                    const bf16_t* qp = Pb + (size_t)(t0 + s) * LDP + C_RQ + h * 64 + ic; unpack8(ld16(qp), a1); unpack8(ld16(qp + 32), a2);
                    const bf16_t* kp = Pb + (size_t)(t0 + s) * LDP + C_RK + h * 64 + ic; unpack8(ld16(kp), k1); unpack8(ld16(kp + 32), k2);
                    float cs[8], sn[8]; ldw8(ROTC + (t0 + s) * 32 + ic, cs); ldw8(ROTS + (t0 + s) * 32 + ic, sn);
#pragma unroll
                    for (int j = 0; j < 8; ++j) { o1[j] = a1[j] * cs[j] - a2[j] * sn[j]; o2[j] = a2[j] * cs[j] + a1[j] * sn[j]; }
                    *(LAS u32x4*)(Qs + s * 144 + ic * 2) = pack8(o1); *(LAS u32x4*)(Qs + s * 144 + (32 + ic) * 2) = pack8(o2);
#pragma unroll
                    for (int j = 0; j < 8; ++j) { o1[j] = (k1[j] * cs[j] - k2[j] * sn[j]) * 0.125f; o2[j] = (k2[j] * cs[j] + k1[j] * sn[j]) * 0.125f; }
                    *(LAS u32x4*)(Ks + s * 144 + ic * 2) = pack8(o1); *(LAS u32x4*)(Ks + s * 144 + (32 + ic) * 2) = pack8(o2); }
                { u32x4 raw_[4];
#pragma unroll
                for (int i = 0; i < 4; ++i) { const int task = tid + NTHR * i, s = task & 127, e8 = (task >> 7) * 8; raw_[i] = ld16(Pb + (size_t)(t0 + s) * LDP + C_RV + h * 128 + e8); }
#pragma unroll
                for (int i = 0; i < 4; ++i) { const int task = tid + NTHR * i, s = task & 127, e8 = (task >> 7) * 8; const u32x4 vv = raw_[i];
#pragma unroll
                    for (int j = 0; j < 4; ++j) { *(LAS bf16_t*)(VT + ((e8 + 2 * j) * 136 + s) * 2) = (bf16_t)(vv[j] & 0xffffu); *(LAS bf16_t*)(VT + ((e8 + 2 * j + 1) * 136 + s) * 2) = (bf16_t)(vv[j] >> 16); } } }
                { u32x4 raw_[4];
#pragma unroll
                for (int i = 0; i < 4; ++i) { const int task = tid + NTHR * i, e = task >> 4, dd = task & 15, dir = dd >> 3, dch = (dd & 7) * 8; raw_[i] = ld16(RST + ((size_t)((dir * 32 + bh) * 66 + c) * 128 + e) * 64 + dch); }
#pragma unroll
                for (int i = 0; i < 4; ++i) { const int task = tid + NTHR * i, e = task >> 4, dd = task & 15, dir = dd >> 3, dch = (dd & 7) * 8; *(LAS u32x4*)(ST + e * 272 + (dir * 64 + dch) * 2) = raw_[i]; } }
                __syncthreads();
                {   f32x4 qk[1][8];
#pragma unroll
                    for (int n = 0; n < 8; ++n) qk[0][n] = (f32x4){0.f, 0.f, 0.f, 0.f};
                    wave_mma<1, 8>(qk, Qs + (16 * wave) * 144, 144, Ks, 144, 64, lane);
#pragma unroll
                    for (int j = 0; j < 4; ++j) { const int p = 16 * wave + q * 4 + j;
#pragma unroll
                        for (int nb = 0; nb < 8; ++nb) { const int s = nb * 16 + r, dl = p - s;
                            const float D = (dl > 0) ? __expf(lgf * (float)dl) : ((dl < 0) ? __expf(lgb * (float)(-dl)) : 2.f);
                            *(LAS bf16_t*)(ATT + (p * 136 + s) * 2) = f2bf(qk[0][nb][j] * D); } }
                }
                float qa[16];
                const int pa = tid >> 2, da = (tid & 3) * 16;
                {   float t8[8]; unpack8(*(const LAS u32x4*)(Qs + pa * 144 + da * 2), t8);
#pragma unroll
                    for (int j = 0; j < 8; ++j) qa[j] = t8[j];
                    unpack8(*(const LAS u32x4*)(Qs + pa * 144 + (da + 8) * 2), t8);
#pragma unroll
                    for (int j = 0; j < 8; ++j) qa[8 + j] = t8[j]; }
                __syncthreads();
                {   const float df = __expf(lgf * (float)(pa + 1)), db = __expf(lgb * (float)(128 - pa)); float o[8];
#pragma unroll
                    for (int hh = 0; hh < 2; ++hh) {
#pragma unroll
                        for (int j = 0; j < 8; ++j) o[j] = qa[hh * 8 + j] * df;
                        *(LAS u32x4*)(AP + pa * 272 + (da + hh * 8) * 2) = pack8(o);
#pragma unroll
                        for (int j = 0; j < 8; ++j) o[j] = qa[hh * 8 + j] * db;
                        *(LAS u32x4*)(AP + pa * 272 + (64 + da + hh * 8) * 2) = pack8(o); } }
                __syncthreads();
                f32x4 y[1][8];
#pragma unroll
                for (int n = 0; n < 8; ++n) y[0][n] = (f32x4){0.f, 0.f, 0.f, 0.f};
                wave_mma<1, 8>(y, ATT + (16 * wave) * 272, 272, VT, 272, 128, lane);
                wave_mma<1, 8>(y, AP + (16 * wave) * 272, 272, ST, 272, 128, lane);
#pragma unroll
                for (int j = 0; j < 4; ++j) { const int p = 16 * wave + q * 4 + j; const int t = b * SEQ + t0 + p;
                    float s1 = 0.f;
#pragma unroll
                    for (int nb = 0; nb < 8; ++nb) s1 += y[0][nb][j];
                    const float mean = row16_sum(s1) * (1.f / 128.f);
                    float s2 = 0.f;
#pragma unroll
                    for (int nb = 0; nb < 8; ++nb) { const float a = y[0][nb][j] - mean; s2 += a * a; }
                    const float rstd = rsqrtf(row16_sum(s2) * (1.f / 128.f) + 1e-6f);
#pragma unroll
                    for (int nb = 0; nb < 8; ++nb) { const int e = nb * 16 + r; *(LAS bf16_t*)(ATT + (p * 136 + e) * 2) = f2bf((y[0][nb][j] - mean) * rstd); } }
                __syncthreads();
                {   u32x4 gr_[4];
#pragma unroll
                    for (int i = 0; i < 4; ++i) { const int task = tid + NTHR * i, p = task >> 4, e8 = (task & 15) * 8; gr_[i] = ld16(P + (size_t)(b * SEQ + t0 + p) * LDP + C_RG + h * 128 + e8); }
#pragma unroll
                    for (int i = 0; i < 4; ++i) { const int task = tid + NTHR * i, p = task >> 4, e8 = (task & 15) * 8; float yv[8], gv[8];
                        unpack8(*(const LAS u32x4*)(ATT + (p * 136 + e8) * 2), yv); unpack8(gr_[i], gv);
#pragma unroll
                        for (int jj = 0; jj < 8; ++jj) yv[jj] *= gv[jj] * sigmoidf_(gv[jj]);
                        *(u32x4*)(YRG + (size_t)(b * SEQ + t0 + p) * 1024 + h * 128 + e8) = pack8(yv); } }
                __syncthreads();
            }
        }
    }
    }
    SEAM(5);

    for (int rep_ = 0; rep_ < NREP(6); ++rep_) { if (rep_) xcd_barrier(bar);
    if (IN(6)) {
        pg8::StaticOrder S; S.init(NTOK, DM, G, bx);
        { pg8::Gemm g{(const bf16_t*)(ws + WS_YRG), (const bf16_t*)(ws + WS_WRO), 1024, 1024}; pg8::EpiU<0> E{P, (bf16_t*)(ws + WS_U), C_GR}; pg8::gemm_phase<pg8::EpiU<0>, pg8::StaticOrder>(lds, g, S, E); }
        { pg8::Gemm g{(const bf16_t*)(ws + WS_YMG), (const bf16_t*)(ws + WS_WMO), 1024, 1024}; pg8::EpiU<1> E{P, (bf16_t*)(ws + WS_U), C_GM}; pg8::gemm_phase<pg8::EpiU<1>, pg8::StaticOrder>(lds, g, S, E); }
    }
    }
    SEAM(6);

    for (int rep_ = 0; rep_ < NREP(7); ++rep_) { if (rep_) xcd_barrier(bar);
    if (IN(7)) {
        pg8::StaticOrder S; S.init(NTOK, DM, G, bx);
        pg8::Gemm g{(const bf16_t*)(ws + WS_U), (const bf16_t*)(ws + WS_WO), DM, DM}; pg8::EpiX1 E{args.in[IN_X], MOD, (bf16_t*)(ws + WS_X1), (float*)(ws + WS_ROWSQ)};
        pg8::gemm_phase<pg8::EpiX1, pg8::StaticOrder>(lds, g, S, E);
    }
    }
    SEAM(7);

    for (int rep_ = 0; rep_ < NREP(8); ++rep_) { if (rep_) xcd_barrier(bar);
    if (IN(8)) {
        const float* g2 = args.in[IN_N2G]; const float* rowsq = (const float*)(ws + WS_ROWSQ); bf16_t* H2 = (bf16_t*)(ws + WS_H2); const bf16_t* x1 = (const bf16_t*)(ws + WS_X1);
        for (int row = gw; row < NTOK; row += NGW) {
            const int b = row >> 13;
            float ss = (lane < 32) ? rowsq[(size_t)lane * NTOK + row] : 0.f;
            const float* shp = MOD + b * 12288 + 3 * DM; const float* scp = shp + DM;
            u32x2 vq[8]; f32x4 gq[8], shq[8], scq[8];
#pragma unroll
            for (int j = 0; j < 8; ++j) { const int idx = 4 * (lane + 64 * j); vq[j] = *(const u32x2*)(x1 + (size_t)row * DM + idx); gq[j] = *(const f32x4*)(g2 + idx); shq[j] = *(const f32x4*)(shp + idx); scq[j] = *(const f32x4*)(scp + idx); }
            const float rstd = rsqrtf(wave_sum(ss) * (1.f / DM) + 1e-6f);
#pragma unroll
            for (int j = 0; j < 8; ++j) { const int idx = 4 * (lane + 64 * j);
                const f32x4 vv = {__uint_as_float(vq[j].x << 16), __uint_as_float(vq[j].x & 0xffff0000u), __uint_as_float(vq[j].y << 16), __uint_as_float(vq[j].y & 0xffff0000u)};
                const f32x4 hv = vv * rstd * gq[j] * (scq[j] + 1.f) + shq[j]; u32x2 o; o.x = pk2(hv[0], hv[1]); o.y = pk2(hv[2], hv[3]); *(u32x2*)(H2 + (size_t)row * DM + idx) = o; }
        }
        { u32x4* ix = (u32x4*)(ws + WS_IDX); const u32x4 inv = {0xFFF0FFF0u, 0xFFF0FFF0u, 0xFFF0FFF0u, 0xFFF0FFF0u};
          for (int i = gt; i < 64 * 16 * 512 * 16 * 2 / 16; i += NGT) ix[i] = inv; }
        const float* pd = args.in[IN_PD]; const float* pu = args.in[IN_PU]; bf16_t* d16 = (bf16_t*)(ws + WS_DN16); _Float16* u16 = (_Float16*)(ws + WS_UP16);
        for (int i = gt; i < 2 * (16384 * DM / 8); i += NGT) { const int which = i >= (16384 * DM / 8); const size_t k = (size_t)(which ? i - 16384 * DM / 8 : i) * 8;
            const float* s = (which ? pu : pd) + k; const f32x4 a = *(const f32x4*)s, b2 = *(const f32x4*)(s + 4);
            if (which) { half8_t o; o[0] = (_Float16)a[0]; o[1] = (_Float16)a[1]; o[2] = (_Float16)a[2]; o[3] = (_Float16)a[3]; o[4] = (_Float16)b2[0]; o[5] = (_Float16)b2[1]; o[6] = (_Float16)b2[2]; o[7] = (_Float16)b2[3]; *(half8_t*)(u16 + k) = o; }
            else { u32x4 o; o.x = pk2(a[0], a[1]); o.y = pk2(a[2], a[3]); o.z = pk2(b2[0], b2[1]); o.w = pk2(b2[2], b2[3]); *(u32x4*)(d16 + k) = o; } }
    }
    }
    SEAM(8);

    for (int rep_ = 0; rep_ < NREP(9); ++rep_) { if (rep_) xcd_barrier(bar);
    if (IN(9)) {
        pg8::StaticOrder S; S.init(NTOK, DM, G, bx);
        pg8::Gemm g{(const bf16_t*)(ws + WS_H2), (const bf16_t*)(ws + WS_WQ), DM, DM}; pg8::EpiQ E{(bf16_t*)(ws + WS_Q)};
        pg8::gemm_phase<pg8::EpiQ, pg8::StaticOrder>(lds, g, S, E);
    }
    }
    SEAM(9);

    for (int rep_ = 0; rep_ < NREP(10); ++rep_) { if (rep_) xcd_barrier(bar);
    if (IN(10)) {
        const bf16_t* Qb = (const bf16_t*)(ws + WS_Q); const bf16_t* K16 = (const bf16_t*)(ws + WS_KEYS); int* EID = (int*)(ws + WS_EID); float* GW = (float*)(ws + WS_GW);
        LAS unsigned char* QT = lds;
        LAS unsigned char* KY = lds + 67584;
        LAS unsigned* LST = (LAS unsigned*)(lds + 137216);
        int hprev = -1;
        u32x4 qn[8];
        if (bx < 2048) {
#pragma unroll
            for (int i = 0; i < 8; ++i) { const int task = tid + NTHR * i, tok = task >> 5, c8 = (task & 31) * 8; qn[i] = ld16(Qb + (size_t)((bx >> 3) * 128 + tok) * DM + (bx & 7) * 256 + c8); } }
        for (int u = bx; u < 2048; u += G) {
            const int tb = u >> 3, h = u & 7;
#pragma unroll
            for (int i = 0; i < 8; ++i) { const int task = tid + NTHR * i, tok = task >> 5, c8 = (task & 31) * 8; *(LAS u32x4*)(QT + tok * 528 + c8 * 2) = qn[i]; }
            if (h != hprev) { u32x4 raw_[8]; hprev = h;
#pragma unroll
            for (int i = 0; i < 8; ++i) { const int task = tid + NTHR * i, row = task >> 4, c8 = (task & 15) * 8; raw_[i] = ld16(K16 + ((size_t)h * 256 + row) * 128 + c8); }
#pragma unroll
            for (int i = 0; i < 8; ++i) { const int task = tid + NTHR * i, row = task >> 4, c8 = (task & 15) * 8; *(LAS u32x4*)(KY + row * 272 + c8 * 2) = raw_[i]; } }
            __syncthreads();
            if (u + G < 2048) { const int un = u + G;
#pragma unroll
                for (int i = 0; i < 8; ++i) { const int task = tid + NTHR * i, tok = task >> 5, c8 = (task & 31) * 8; qn[i] = ld16(Qb + (size_t)((un >> 3) * 128 + tok) * DM + (un & 7) * 256 + c8); } }
            const int r = lane & 15, q = lane >> 4;
            float L0[16], L1[16];
#pragma unroll
            for (int pp = 0; pp < 2; ++pp) {
                f32x4 sc[8][1];
#pragma unroll
                for (int mb = 0; mb < 8; ++mb) sc[mb][0] = (f32x4){0.f, 0.f, 0.f, 0.f};
                wave_mma<8, 1>(sc, KY + (pp * 128) * 272, 272, QT + (16 * wave) * 528 + pp * 256, 528, 128, lane);
                float L[16];
#pragma unroll
                for (int i = 0; i < 16; ++i) L[i] = -__builtin_inff();
#pragma unroll
                for (int mb = 0; mb < 8; ++mb)
#pragma unroll
                    for (int j = 0; j < 4; ++j) { const unsigned key = (unsigned)(mb * 16 + q * 4 + j);
                        ins16(L, __uint_as_float((__float_as_uint(sc[mb][0][j]) & ~127u) | key)); }
#pragma unroll
                for (int sh = 16; sh <= 32; sh <<= 1) { float o[16];
#pragma unroll
                    for (int i = 0; i < 16; ++i) o[i] = __shfl_xor(L[i], sh);
#pragma unroll
                    for (int i = 0; i < 16; ++i) ins16(L, o[i]); }
#pragma unroll
                for (int i = 0; i < 16; ++i) { if (pp == 0) L0[i] = L[i]; else L1[i] = L[i]; }
            }
            if (q == 0) {
#pragma unroll
                for (int i = 0; i < 16; ++i) { LST[(16 * wave + r) * 32 + i] = __float_as_uint(L0[i]); LST[(16 * wave + r) * 32 + 16 + i] = __float_as_uint(L1[i]); } }
            float T[16];
#pragma unroll
            for (int i = 0; i < 16; ++i) T[i] = -__builtin_inff();
#pragma unroll
            for (int a = 0; a < 16; ++a)
#pragma unroll
                for (int b2 = 0; b2 < 16; ++b2) if ((a + 1) * (b2 + 1) <= 16) { const float cnd = L0[a] + L1[b2]; ins16(T, __uint_as_float((__float_as_uint(cnd) & ~255u) | (unsigned)(a * 16 + b2))); }
            __syncthreads();
            float den = 0.f, ev[16];
#pragma unroll
            for (int i = 0; i < 16; ++i) { ev[i] = __expf(T[i] - T[0]); den += ev[i]; }
            const float rden = 1.f / den;
            const int tok = 16 * wave + r; const size_t ob = (size_t)(tb * 128 + tok) * 128 + h * 16 + q * 4;
#pragma unroll
            for (int kk = 0; kk < 4; ++kk) {
                const float tv = (q == 0) ? T[kk] : (q == 1 ? T[4 + kk] : (q == 2 ? T[8 + kk] : T[12 + kk]));
                const float gv = (q == 0) ? ev[kk] : (q == 1 ? ev[4 + kk] : (q == 2 ? ev[8 + kk] : ev[12 + kk]));
                const unsigned code = __float_as_uint(tv) & 255u;
                const unsigned i1 = LST[tok * 32 + (code >> 4)] & 127u, i2 = LST[tok * 32 + 16 + (code & 15u)] & 127u;
                EID[ob + kk] = (int)(i1 * 128u + i2); GW[ob + kk] = gv * rden; }
            __syncthreads();
        }
    }
    }
    SEAM(10);

    for (int rep_ = 0; rep_ < NREP(11); ++rep_) { if (rep_) xcd_barrier(bar);
    if (IN(11)) {
        const int* EID = (const int*)(ws + WS_EID); const float* GW = (const float*)(ws + WS_GW);
        unsigned short* IDX = (unsigned short*)(ws + WS_IDX); float* GJ = (float*)(ws + WS_GJ);
        int* OVC = (int*)(ws + WS_OVC); unsigned* OVE = (unsigned*)(ws + WS_OVE);
        for (int cku = gw; cku < NTOK / 8; cku += NGW) {
            const int hh = lane & 7, t = cku * 8 + (lane >> 3), TBi = t >> 9, tl = t & 511;
            int eid[16]; float gg[16];
#pragma unroll
            for (int q4 = 0; q4 < 4; ++q4) { const u32x4 e4 = *(const u32x4*)(EID + (size_t)t * 128 + hh * 16 + 4 * q4); const f32x4 g4v = *(const f32x4*)(GW + (size_t)t * 128 + hh * 16 + 4 * q4);
#pragma unroll
                for (int i = 0; i < 4; ++i) { eid[4 * q4 + i] = (int)e4[i]; gg[4 * q4 + i] = g4v[i]; } }
            unsigned hc[4] = {0u, 0u, 0u, 0u};
#pragma unroll
            for (int k = 0; k < 16; ++k) { const unsigned eb = EBLK(eid[k]), inc = 1u << ((eb & 3u) * 8u), sel = eb >> 2;
#pragma unroll
                for (int w4 = 0; w4 < 4; ++w4) hc[w4] += (sel == (unsigned)w4) ? inc : 0u; }
            unsigned run[4];
#pragma unroll
            for (int w4 = 0; w4 < 4; ++w4) { unsigned v = hc[w4];
#pragma unroll
                for (int o = 1; o < 8; o <<= 1) { const unsigned uu = (unsigned)__shfl_up((int)v, o, 8); if (hh >= o) v += uu; }
                run[w4] = v - hc[w4]; }
            int ovown = 0;
#pragma unroll
            for (int e = 0; e < 16; ++e) { const int bs = (int)((run[e >> 2] >> ((e & 3) * 8)) & 255u), ow = (int)((hc[e >> 2] >> ((e & 3) * 8)) & 255u);
                const int lo = bs > LCAP ? bs : LCAP; ovown += (bs + ow > lo) ? (bs + ow - lo) : 0; }
            int ovinc = ovown;
#pragma unroll
            for (int o = 1; o < 8; o <<= 1) { const int uu = __shfl_up(ovinc, o, 8); if (hh >= o) ovinc += uu; }
            int ovpos = ovinc - ovown;
            if (hh == 7) OVC[t] = ovinc;
            if (hh == 7) { unsigned char* CNT = (unsigned char*)(ws + WS_NMAXG);
#pragma unroll
                for (int e = 0; e < 16; ++e) { const unsigned tot = ((run[e >> 2] + hc[e >> 2]) >> ((e & 3) * 8)) & 255u; CNT[(size_t)(TBi * 16 + e) * 512 + tl] = (unsigned char)(tot < (unsigned)LCAP ? tot : (unsigned)LCAP); } }
#pragma unroll
            for (int k = 0; k < 16; ++k) { const unsigned eb = EBLK(eid[k]), sh = (eb & 3u) * 8u, sel = eb >> 2;
                const unsigned cur = (sel == 0u) ? run[0] : (sel == 1u ? run[1] : (sel == 2u ? run[2] : run[3]));
                const unsigned j = (cur >> sh) & 255u;
#pragma unroll
                for (int w4 = 0; w4 < 4; ++w4) run[w4] += (sel == (unsigned)w4) ? (1u << sh) : 0u;
                if (j < (unsigned)LCAP) { const unsigned el = EROWIN(eid[k]);
                    IDX[((size_t)(TBi * 16 + eb) * 512 + tl) * 16 + j] = (unsigned short)(((el << 2) | (el & 3u)) << 4); GJ[((size_t)(TBi * 16 + eb) * LCAP + j) * 512 + tl] = gg[k]; }
                else { OVE[((size_t)t * 128 + ovpos) * 2] = (unsigned)eid[k]; OVE[((size_t)t * 128 + ovpos) * 2 + 1] = __float_as_uint(gg[k]); ++ovpos; }
            }
        }
    }
    }
    SEAM(11);

    for (int rep_ = 0; rep_ < NREP(12); ++rep_) { if (rep_) xcd_barrier(bar);
    if (IN(12)) {
        const bf16_t* H2 = (const bf16_t*)(ws + WS_H2); const bf16_t* d16 = (const bf16_t*)(ws + WS_DN16);
        const unsigned short* IDX = (const unsigned short*)(ws + WS_IDX); const float* GJ = (const float*)(ws + WS_GJ); unsigned* EW = (unsigned*)(ws + WS_EW);
        LAS unsigned char* IDL = lds + 131072;
        for (int u = bx; u < 512; u += G) {
            int tid = threadIdx.x; asm volatile("" : "+v"(tid)); const int lane = tid & 63;
            const int xx = u & 7, rest = u >> 3, wq = rest & 31, eb = wq & 15, TBi = 4 * xx + 2 * (rest >> 5) + (wq >> 4);
            const int c4 = lane & 3, g4 = lane >> 2;
            LAS unsigned short* PERMS = (LAS unsigned short*)(lds + 155648); LAS unsigned* HIST = (LAS unsigned*)(lds + 157696); LAS unsigned char* CNTL = lds + 157760;
            __syncthreads();
            if (tid < 16) HIST[tid] = 0u;
            unsigned cnt2[2];
#pragma unroll
            for (int k2 = 0; k2 < 2; ++k2) { const int i = tid + NTHR * k2; const size_t hb = (size_t)((TBi * 2 + (i >> 9)) * 16 + eb) * 512 + (i & 511);
                const u32x4 e0 = *(const u32x4*)(IDX + hb * 16); const u32x2 e1 = *(const u32x2*)(IDX + hb * 16 + 8);
                *(LAS u32x2*)(IDL + i * 24) = (u32x2){e0[0], e0[1]}; *(LAS u32x2*)(IDL + i * 24 + 8) = (u32x2){e0[2], e0[3]}; *(LAS u32x2*)(IDL + i * 24 + 16) = e1;
                cnt2[k2] = ((const unsigned char*)(ws + WS_NMAXG))[hb]; CNTL[i] = (unsigned char)cnt2[k2]; }
            __syncthreads();
            unsigned rank2[2];
#pragma unroll
            for (int k2 = 0; k2 < 2; ++k2) rank2[k2] = __hip_atomic_fetch_add(&HIST[cnt2[k2]], 1u, __ATOMIC_RELAXED, __HIP_MEMORY_SCOPE_WORKGROUP);
            __syncthreads();
#pragma unroll
            for (int k2 = 0; k2 < 2; ++k2) { unsigned base = 0u; for (unsigned c2 = cnt2[k2] + 1u; c2 <= (unsigned)LCAP; ++c2) base += HIST[c2]; PERMS[base + rank2[k2]] = (unsigned short)(tid + NTHR * k2); }
            __syncthreads();
            int tlg[8], nmx[8];
#pragma unroll
            for (int grp = 0; grp < 8; ++grp) { tlg[grp] = PERMS[wave * 128 + grp * 16 + g4]; nmx[grp] = __builtin_amdgcn_readfirstlane((int)CNTL[PERMS[wave * 128 + grp * 16]]); }
            float acc[8][LCAP];
#pragma unroll
            for (int grp = 0; grp < 8; ++grp)
#pragma unroll
                for (int j = 0; j < LCAP; ++j) acc[grp][j] = 0.f;
            const bf16_t* dsrc = d16;
            const bf16_t* hsrc = H2 + (size_t)(TBi * 1024) * DM + c4 * 8;
#define DN_DMA1(fbv, bufv, i2) do { const int Lb = (i2) * 8192 + wave * 1024 + lane * 16, r = Lb >> 6, cp = (Lb >> 4) & 3; \
                __builtin_amdgcn_global_load_lds((const unsigned*)(dsrc + (size_t)EROW(eb, r) * DM + (fbv) * 32 + ((cp ^ (r & 3)) * 8)), (LAS unsigned*)(lds + (bufv) * 65536 + (i2) * 8192 + wave * 1024), 16, 0, 0); } while (0)
            u32x4 hq[8];
#pragma unroll
            for (int i2 = 0; i2 < 8; ++i2) DN_DMA1(0, 0, i2);
#pragma unroll
            for (int grp = 0; grp < 8; ++grp) hq[grp] = ld16(hsrc + (size_t)tlg[grp] * DM);
            asm volatile("s_waitcnt vmcnt(0)" ::: "memory");
            __syncthreads();
            const u32x2 ea0 = *(const LAS u32x2*)(IDL + tlg[0] * 24), eb0 = *(const LAS u32x2*)(IDL + tlg[0] * 24 + 8), ec0 = *(const LAS u32x2*)(IDL + tlg[0] * 24 + 16);
            u32x2 ean = ea0, ebn = eb0, ecn = ec0;
#pragma unroll 1
            for (int fb = 0; fb < 64; ++fb) {
                const bool more = (fb + 1 < 64);
                const unsigned boff = (unsigned)(fb & 1) << 16, c4s = (unsigned)c4 << 4;
#pragma unroll
                for (int grp = 0; grp < 8; ++grp) {
                    const u32x2 ea = ean, ebb = ebn, ec = ecn;
                    if (grp + 1 < 8) { const LAS unsigned char* ipn = IDL + tlg[grp + 1] * 24; ean = *(const LAS u32x2*)ipn; ebn = *(const LAS u32x2*)(ipn + 8); ecn = *(const LAS u32x2*)(ipn + 16); }
                    else { ean = ea0; ebn = eb0; ecn = ec0; }
                    if (grp >= 3) { if (more) { if (grp == 3) asm volatile("s_waitcnt vmcnt(13)" ::: "memory"); else asm volatile("s_waitcnt vmcnt(15)" ::: "memory"); }
                                    else { if (grp == 3) asm volatile("s_waitcnt vmcnt(4)" ::: "memory"); else if (grp == 4) asm volatile("s_waitcnt vmcnt(3)" ::: "memory"); else if (grp == 5) asm volatile("s_waitcnt vmcnt(2)" ::: "memory");
                                           else if (grp == 6) asm volatile("s_waitcnt vmcnt(1)" ::: "memory"); else asm volatile("s_waitcnt vmcnt(0)" ::: "memory"); } }
#pragma unroll
                    for (int jb = 0; jb < LCAP; jb += 4) {
                        const int bt = grp * 3 + (jb >> 2);
                        if (more && (bt % 3 == 0) && bt < 12) {
#pragma unroll
                            for (int i2 = 0; i2 < 2; ++i2) DN_DMA1(fb + 1, (fb + 1) & 1, (bt / 3) * 2 + i2); }
                        if (jb < nmx[grp]) {
                        u32x4 v[4];
#pragma unroll
                        for (int jj = 0; jj < 4; ++jj) { const int j = jb + jj; const unsigned wd = (j < 4) ? ea[j >> 1] : (j < 8 ? ebb[(j - 4) >> 1] : ec[(j - 8) >> 1]); const unsigned ko = (j & 1) ? (wd >> 16) : (wd & 0xFFFFu);
                            v[jj] = *(const LAS u32x4*)(lds + ((ko ^ c4s) + boff)); }
#pragma unroll
                        for (int jj = 0; jj < 4; ++jj) { float a = acc[grp][jb + jj];
#pragma unroll
                            for (int q4 = 0; q4 < 4; ++q4) { const unsigned xa = v[jj][q4], xb = hq[grp][q4]; a = __builtin_amdgcn_fdot2_f32_bf16(__builtin_bit_cast(bf16x2_t, xa), __builtin_bit_cast(bf16x2_t, xb), a, false); }
                            acc[grp][jb + jj] = a; }
                        }
                        __builtin_amdgcn_sched_barrier(0);
                    }
                    if (more) { const bf16_t* hp = hsrc + (size_t)tlg[grp] * DM + (fb + 1) * 32; asm volatile("global_load_dwordx4 %0, %1, off" : "=v"(hq[grp]) : "v"(hp) : "memory"); }
                }
                asm volatile("s_waitcnt vmcnt(5)" ::: "memory");
                __builtin_amdgcn_s_barrier();
            }
#undef DN_DMA1
#pragma unroll
            for (int grp = 0; grp < 8; ++grp) {
                const int tl = tlg[grp]; const size_t hb = (size_t)((TBi * 2 + (tl >> 9)) * 16 + eb);
                const int cnt = (int)CNTL[tl];
                float sm[3], gj[3];
#pragma unroll
                for (int jq = 0; jq < 3; ++jq) {
#pragma unroll
                    for (int i = 0; i < 4; ++i) { float sacc = acc[grp][4 * jq + i]; sacc += __shfl_xor(sacc, 1); sacc += __shfl_xor(sacc, 2); if (i == 0) sm[jq] = sacc; else sm[jq] = (c4 == i) ? sacc : sm[jq]; } }
#pragma unroll
                for (int jq = 0; jq < 3; ++jq) { const int j = 4 * jq + c4; gj[jq] = (j < cnt) ? GJ[(hb * LCAP + j) * 512 + (tl & 511)] : 0.f; }
#pragma unroll
                for (int jq = 0; jq < 3; ++jq) { const int j = 4 * jq + c4; const unsigned ent = *(const LAS unsigned short*)(IDL + tl * 24 + j * 2);
                    unsigned o = 0u;
                    if (j < cnt) { const _Float16 wh = (_Float16)(gj[jq] * gelu_erf(sm[jq])); o = (ent & 0xFFC0u) | ((unsigned)__builtin_bit_cast(unsigned short, wh) << 16); }
                    EW[((size_t)(TBi * 16 + eb) * 1024 + tl) * LCAP + j] = o; }
            }
        }
    }
    }
    SEAM(12);

    for (int rep_ = 0; rep_ < NREP(13); ++rep_) { if (rep_) xcd_barrier(bar);
    if (IN(13)) {
        const _Float16* u16 = (const _Float16*)(ws + WS_UP16); const unsigned* EW = (const unsigned*)(ws + WS_EW);
        float* out = args.out;
        {
            const bf16_t* H2o = (const bf16_t*)(ws + WS_H2); const bf16_t* d16o = (const bf16_t*)(ws + WS_DN16);
            const int* OVC = (const int*)(ws + WS_OVC); unsigned* OVE = (unsigned*)(ws + WS_OVE);
            int novN = (gw < NTOK) ? OVC[gw] : 0; u32x4 oN = (gw < NTOK) ? *(const u32x4*)(OVE + (size_t)gw * 256) : (u32x4){0u, 0u, 0u, 0u};
            for (int t = gw; t < NTOK; t += NGW) {
                const int nov = __builtin_amdgcn_readfirstlane(novN); const u32x4 o01 = oN;
                if (t + NGW < NTOK) { novN = OVC[t + NGW]; oN = *(const u32x4*)(OVE + (size_t)(t + NGW) * 256); }
                if (nov > 0) {
                    u32x4 hx[4];
#pragma unroll
                    for (int j = 0; j < 4; ++j) hx[j] = ld16(H2o + (size_t)t * DM + 8 * (lane + 64 * j));
                    for (int k0 = 0; k0 < nov; k0 += 2) {
                        u32x4 dr[2][4]; float gk[2];
#pragma unroll
                        for (int kk = 0; kk < 2; ++kk) { const bool ok = (k0 + kk < nov); const int k = ok ? k0 + kk : k0;
                            const unsigned eu = (k0 == 0) ? ((kk == 1 && ok) ? o01.z : o01.x) : OVE[((size_t)t * 128 + k) * 2], gu = (k0 == 0) ? ((kk == 1 && ok) ? o01.w : o01.y) : OVE[((size_t)t * 128 + k) * 2 + 1];
                            const int e = __builtin_amdgcn_readfirstlane((int)eu); gk[kk] = __uint_as_float(gu);
#pragma unroll
                            for (int j = 0; j < 4; ++j) dr[kk][j] = ld16(d16o + (size_t)e * DM + 8 * (lane + 64 * j)); }
#pragma unroll
                        for (int kk = 0; kk < 2; ++kk) { float sdot = 0.f;
#pragma unroll
                            for (int j = 0; j < 4; ++j)
#pragma unroll
                                for (int q4 = 0; q4 < 4; ++q4) { const unsigned xa = dr[kk][j][q4], xb = hx[j][q4]; sdot = __builtin_amdgcn_fdot2_f32_bf16(__builtin_bit_cast(bf16x2_t, xa), __builtin_bit_cast(bf16x2_t, xb), sdot, false); }
                            sdot = wave_sum(sdot);
                            if (k0 + kk < nov && lane == 0) OVE[((size_t)t * 128 + k0 + kk) * 2 + 1] = pk2(0.f, gk[kk] * gelu_erf(sdot)) & 0xffff0000u; }
                    }
                }
            }
        }
        if (bx < 2048) {
            int tid = threadIdx.x; asm volatile("" : "+v"(tid)); const int lane = tid & 63;
            const int c4 = lane & 3, g4 = lane >> 2;
            const unsigned evo = (unsigned)(wave * 128 + g4) * (LCAP * 4u);
#define UP_DMA1(srcv, ebv, bufv, i2) do { const int Lb = (i2) * 8192 + wave * 1024 + lane * 16, r = Lb >> 6, cp = (Lb >> 4) & 3; \
                __builtin_amdgcn_global_load_lds((const unsigned*)((srcv) + (size_t)EROW(ebv, r) * DM + (cp * 8)), (LAS unsigned*)(lds + (bufv) * 65536 + (i2) * 8192 + wave * 1024), 16, 0, 0); } while (0)
            u32x4 ew[8][3];
            {
                const int TB0 = (bx >> 3) & 31, fb0 = (bx & 7) + 8 * (bx >> 8);
                const _Float16* usrc0 = u16 + fb0 * 32; const unsigned* esrc = EW + ((size_t)(TB0 * 16) * 1024 + wave * 128 + g4) * LCAP;
                __syncthreads();
#pragma unroll
                for (int i2 = 0; i2 < 8; ++i2) UP_DMA1(usrc0, 0, 0, i2);
#pragma unroll
                for (int grp = 0; grp < 8; ++grp)
#pragma unroll
                    for (int j = 0; j < 3; ++j) ew[grp][j] = *(const u32x4*)(esrc + (size_t)grp * 16 * LCAP + 4 * j);
                asm volatile("s_waitcnt vmcnt(0)" ::: "memory");
                __syncthreads();
            }
        for (int u = bx; u < 2048; u += G) {
            const int xx = u & 7, rest = u >> 3, TBi = rest & 31, fb = xx + 8 * (rest >> 5);
            const bool hasNext = (u + G < 2048); const int uN = hasNext ? u + G : u, TBiN = (uN >> 3) & 31, fbN = (uN & 7) + 8 * (uN >> 8);
            float acc[8][8];
#pragma unroll
            for (int grp = 0; grp < 8; ++grp)
#pragma unroll
                for (int i = 0; i < 8; ++i) acc[grp][i] = 0.f;
            const _Float16* usrc = u16 + fb * 32; const _Float16* usrcN = u16 + fbN * 32;
#pragma unroll 1
            for (int eb = 0; eb < 16; ++eb) {
                const bool inUnit = (eb + 1 < 16), more = inUnit || hasNext;
                const int nb = (eb + 1) & 15, TBx = inUnit ? TBi : TBiN; const _Float16* usrcX = inUnit ? usrc : usrcN;
                const unsigned kb = (unsigned)(size_t)lds + ((unsigned)(eb & 1) << 16) + ((unsigned)c4 << 4);
#define UP_ADDR(e_) ({ unsigned a_; asm("v_add_u32_sdwa %0, %1, %2 dst_sel:DWORD dst_unused:UNUSED_PAD src0_sel:WORD_0 src1_sel:DWORD" : "=v"(a_) : "v"(e_), "v"(kb)); a_; })
                u32x4 vc[4], vn[4];
#pragma unroll
                for (int jj = 0; jj < 4; ++jj) vc[jj] = *(const LAS u32x4*)(size_t)UP_ADDR(ew[0][0][jj]);
                unsigned a16[4];
#pragma unroll
                for (int bt = 0; bt < 24; ++bt) {
                    const int grp = bt / 3, jb = (bt % 3) * 4;
                    if (jb == 0) {
#pragma unroll
                        for (int q4 = 0; q4 < 4; ++q4) a16[q4] = 0u; }
                    if (more && (bt % 4 == 0) && bt < 16) {
#pragma unroll
                        for (int i2 = 0; i2 < 2; ++i2) UP_DMA1(usrcX, nb, (eb + 1) & 1, (bt / 4) * 2 + i2); }
                    if (bt == 16) {
                        if (more) asm volatile("s_waitcnt vmcnt(23)" ::: "memory");
                        else asm volatile("s_waitcnt vmcnt(0)" ::: "memory"); }
                    if (bt + 1 < 24) { const int g2 = (bt + 1) / 3, j2 = ((bt + 1) % 3) * 4;
#pragma unroll
                        for (int jj = 0; jj < 4; ++jj) vn[jj] = *(const LAS u32x4*)(size_t)UP_ADDR(ew[g2][j2 >> 2][jj]); }
#pragma unroll
                    for (int jj = 0; jj < 4; ++jj) {
#pragma unroll
                        for (int q4 = 0; q4 < 4; ++q4) { const unsigned xv = vc[jj][q4]; asm("v_pk_fma_f16 %0, %1, %2, %0 op_sel:[0,1,0] op_sel_hi:[1,1,1]" : "+v"(a16[q4]) : "v"(xv), "v"(ew[grp][jb >> 2][jj])); } }
                    if (jb == 8) {
#pragma unroll
                        for (int q4 = 0; q4 < 4; ++q4) { const unsigned ab = a16[q4]; acc[grp][2 * q4] = fmix_lo(1.0f, ab, acc[grp][2 * q4]); acc[grp][2 * q4 + 1] = fmix_hi(1.0f, ab, acc[grp][2 * q4 + 1]); }
                        if (more) {
#pragma unroll
                            for (int j = 0; j < 3; ++j) { const unsigned* ep = EW + (size_t)(TBx * 16 + nb) * 1024 * LCAP + (grp >> 2) * (64 * LCAP);
                                asm volatile("global_load_dwordx4 %0, %1, %2 offset:%3" : "=v"(ew[grp][j]) : "v"(evo), "s"(ep), "n"((grp & 3) * 16 * LCAP * 4 + j * 16) : "memory"); } } }
#pragma unroll
                    for (int jj = 0; jj < 4; ++jj) vc[jj] = vn[jj];
                }
                asm volatile("s_waitcnt vmcnt(6)" ::: "memory");
                __builtin_amdgcn_s_barrier();
            }
#undef UP_ADDR
            {
                const int col = fb * 32 + c4 * 8; const int bb = (TBi * 1024) >> 13;
                const float* gp = MOD + bb * 12288 + 5 * DM + col; const f32x4 gv0 = *(const f32x4*)gp, gv1 = *(const f32x4*)(gp + 4);
                bf16_t* X1 = (bf16_t*)(ws + WS_X1);
                u32x4 xq[8];
#pragma unroll
                for (int grp = 0; grp < 8; ++grp) xq[grp] = *(const u32x4*)(X1 + (size_t)(TBi * 1024 + wave * 128 + grp * 16 + g4) * DM + col);
#pragma unroll
                for (int grp = 0; grp < 8; ++grp) { float xf[8]; unpack8(xq[grp], xf);
#pragma unroll
                    for (int i = 0; i < 4; ++i) { xf[i] += gv0[i] * acc[grp][i]; xf[4 + i] += gv1[i] * acc[grp][4 + i]; }
                    *(u32x4*)(X1 + (size_t)(TBi * 1024 + wave * 128 + grp * 16 + g4) * DM + col) = pack8(xf); } }
        }
#undef UP_DMA1
        }
    }
    }
    SEAM(13);

    if (IN(14)) {
        const _Float16* u16 = (const _Float16*)(ws + WS_UP16);
        const int* OVC = (const int*)(ws + WS_OVC); const unsigned* OVE = (const unsigned*)(ws + WS_OVE); const float* fg = args.in[IN_FG]; float* out = args.out;
        f32x4 fgq[4][2];
#pragma unroll
        for (int j = 0; j < 4; ++j)
#pragma unroll
            for (int hh = 0; hh < 2; ++hh) fgq[j][hh] = *(const f32x4*)(fg + 8 * (lane + 64 * j) + 4 * hh);
        int novN = (gw < NTOK) ? OVC[gw] : 0; u32x4 oN = (gw < NTOK) ? *(const u32x4*)(OVE + (size_t)gw * 256) : (u32x4){0u, 0u, 0u, 0u};
        for (int t = gw; t < NTOK; t += NGW) {
            const int b = t >> 13;
            const int nov = __builtin_amdgcn_readfirstlane(novN); const u32x4 o01 = oN;
            if (t + NGW < NTOK) { novN = OVC[t + NGW]; oN = *(const u32x4*)(OVE + (size_t)(t + NGW) * 256); }
            float xr[32];
#pragma unroll
            for (int j = 0; j < 4; ++j) { const int idx = 8 * (lane + 64 * j); unpack8(*(const u32x4*)((const bf16_t*)(ws + WS_X1) + (size_t)t * DM + idx), xr + 8 * j); }
            if (nov > 0) {
                const float* gt2 = MOD + b * 12288 + 5 * DM;
                for (int k0 = 0; k0 < nov; k0 += 2) {
                    half8_t ur[2][4]; float wv[2];
#pragma unroll
                    for (int kk = 0; kk < 2; ++kk) { const bool ok = (k0 + kk < nov); const int k = ok ? k0 + kk : k0;
                        const unsigned eu = (k0 == 0) ? ((kk == 1 && ok) ? o01.z : o01.x) : OVE[((size_t)t * 128 + k) * 2], wu = (k0 == 0) ? ((kk == 1) ? o01.w : o01.y) : OVE[((size_t)t * 128 + k) * 2 + 1];
                        const int e = __builtin_amdgcn_readfirstlane((int)eu); wv[kk] = ok ? __uint_as_float(wu) : 0.f;
#pragma unroll
                        for (int j = 0; j < 4; ++j) ur[kk][j] = *(const half8_t*)(u16 + (size_t)e * DM + 8 * (lane + 64 * j)); }
#pragma unroll
                    for (int kk = 0; kk < 2; ++kk)
#pragma unroll
                        for (int j = 0; j < 4; ++j) { const int idx = 8 * (lane + 64 * j); const f32x4 ga = *(const f32x4*)(gt2 + idx), gb = *(const f32x4*)(gt2 + idx + 4);
#pragma unroll
                            for (int i = 0; i < 4; ++i) { xr[8 * j + i] += ga[i] * wv[kk] * (float)ur[kk][j][i]; xr[8 * j + 4 + i] += gb[i] * wv[kk] * (float)ur[kk][j][4 + i]; } }
                }
            }
            float ss = 0.f;
#pragma unroll
            for (int i = 0; i < 32; ++i) ss += xr[i] * xr[i];
            const float rstd = rsqrtf(wave_sum(ss) * (1.f / DM) + 1e-6f);
#pragma unroll
            for (int j = 0; j < 4; ++j) { const int idx = 8 * (lane + 64 * j);
#pragma unroll
                for (int hh = 0; hh < 2; ++hh) { const f32x4 gq = fgq[j][hh]; f32x4 o;
#pragma unroll
                    for (int i = 0; i < 4; ++i) o[i] = xr[8 * j + 4 * hh + i] * rstd * gq[i];
                    *(f32x4*)(out + (size_t)t * DM + idx + 4 * hh) = o; } }
        }
    }
#undef IN
#undef SEAM
}

extern "C" void kernel_launch(void* const* d_in, const int* in_sizes, int n_in, void* d_out, int out_size, void* d_ws, size_t ws_size, hipStream_t stream) {
    static int grid = 0;
    if (grid == 0) {
        if (n_in != 20 || out_size != NTOK * DM || ws_size < WS_END) { fprintf(stderr, "kernel_launch: unexpected problem (n_in %d, out %d, ws %zu)\n", n_in, out_size, ws_size); grid = -1; return; }
        int dev = 0, cus = 0, per_cu = 0;
        if (hipGetDevice(&dev) != hipSuccess || hipDeviceGetAttribute(&cus, hipDeviceAttributeMultiprocessorCount, dev) != hipSuccess) { grid = -1; return; }
        if (hipFuncSetAttribute((const void*)fwd_kernel, hipFuncAttributeMaxDynamicSharedMemorySize, LDS_BYTES) != hipSuccess) { fprintf(stderr, "kernel_launch: hipFuncSetAttribute failed\n"); grid = -1; return; }
        if (hipOccupancyMaxActiveBlocksPerMultiprocessor(&per_cu, (const void*)fwd_kernel, NTHR, LDS_BYTES) != hipSuccess || per_cu < 1) { fprintf(stderr, "kernel_launch: occupancy query says %d blocks per CU\n", per_cu); grid = -1; (void)hipGetLastError(); return; }
        grid = cus;
    }
    if (grid < 0) return;
    (void)hipMemsetAsync((char*)d_ws + WS_CTL, 0, 64 * 1024, stream);
    Args a{};
    for (int i = 0; i < 20; ++i) a.in[i] = (const float*)d_in[i];
    a.out = (float*)d_out; a.ws = (unsigned char*)d_ws;
#if MK_N_LAUNCHES == 1
    a.ph_lo = 0; a.ph_hi = NPHASES;
    void* kargs[] = {&a};
    hipError_t e = hipLaunchCooperativeKernel((const void*)fwd_kernel, dim3(grid), dim3(NTHR), kargs, LDS_BYTES, stream);
    if (e != hipSuccess) fprintf(stderr, "kernel_launch: cooperative launch failed: %s (grid %d)\n", hipGetErrorString(e), grid);
#else
    for (int p = 0; p < NPHASES; ++p) { a.ph_lo = p; a.ph_hi = p + 1; hipLaunchKernelGGL(fwd_kernel, dim3(grid), dim3(NTHR), LDS_BYTES, stream, a); }
#endif
}
```
